# Optimizing an MI355X kernel written in HIP

```python
import jax, jax.numpy as jnp
from jax import lax
import numpy as np

D_MODEL = 1024
BATCH = 8
SEQ = 2048
DEPTH = 1

N_MEM = 256
GDN_HEADS = 4
GDN_HEAD_DIM = 128
GDN_CONV = 4
GDN_CHUNK = 64
SWA_HEADS = 8
SWA_HEAD_DIM = 64
DILATED_BRANCHES = ((128, 1), (512, 4), (2048, 16))
SWA_BLOCK = 128
MEM_HEADS = 4
MEM_HEAD_DIM = D_MODEL // MEM_HEADS
D_FF = 2816
EPS = 1e-6

GDN_W = GDN_HEADS * GDN_HEAD_DIM
SWA_W = SWA_HEADS * SWA_HEAD_DIM
MIX_W = GDN_W + SWA_W
IN_SIZES = (GDN_W, GDN_W, GDN_W, GDN_W, GDN_HEADS, GDN_HEADS, SWA_W, SWA_W, SWA_W)
IN_COLS = sum(IN_SIZES)
IN_SPLITS = tuple(int(c) for c in np.cumsum(IN_SIZES)[:-1])

kernel_name = "hybrid_gdn_dilated_alibi_macaron_sandwich"


def rms_norm(x, g):
    xf = x.astype(jnp.float32)
    y = xf * lax.rsqrt(jnp.mean(xf * xf, axis=-1, keepdims=True) + EPS)
    return (y * g.astype(jnp.float32)).astype(x.dtype)


def swiglu(x, w_gate, w_up, w_down):
    return (jax.nn.silu(x @ w_gate) * (x @ w_up)) @ w_down


def l2_normalize(x):
    return x * lax.rsqrt(jnp.sum(x * x, axis=-1, keepdims=True) + EPS)


def causal_depthwise_conv(x, w):
    c = x.shape[-1]
    return lax.conv_general_dilated(
        x, w[:, None, :].astype(x.dtype), window_strides=(1,),
        padding=((GDN_CONV - 1, 0),), dimension_numbers=("NWC", "WIO", "NWC"),
        feature_group_count=c)


def gated_delta_chunked(q, k, v, g, beta):
    b_, h_, s_, dk = q.shape
    dv = v.shape[-1]
    c = GDN_CHUNK
    n = s_ // c
    q = q.reshape(b_, h_, n, c, dk)
    k = k.reshape(b_, h_, n, c, dk)
    v = v.reshape(b_, h_, n, c, dv)
    g = jnp.cumsum(g.reshape(b_, h_, n, c), axis=-1)
    beta = beta.reshape(b_, h_, n, c)
    idx = jnp.arange(c)
    tril = idx[:, None] >= idx[None, :]
    strict = idx[:, None] > idx[None, :]
    decay = jnp.exp(jnp.where(tril, g[..., :, None] - g[..., None, :], -jnp.inf))
    k_beta = k * beta[..., None]
    v_beta = v * beta[..., None]
    a = jnp.where(strict, jnp.einsum("bhncd,bhnsd->bhncs", k_beta, k) * decay, 0.0)
    eye = jnp.eye(c, dtype=q.dtype)
    t_mat = lax.linalg.triangular_solve(eye + a, jnp.broadcast_to(eye, a.shape),
                                        left_side=True, lower=True, unit_diagonal=True)
    u = t_mat @ v_beta
    w = t_mat @ (k_beta * jnp.exp(g)[..., None])
    qk = jnp.where(tril, jnp.einsum("bhncd,bhnsd->bhncs", q, k) * decay, 0.0)
    q_dec = q * jnp.exp(g)[..., None]
    k_dec = k * jnp.exp(g[..., -1:] - g)[..., None]
    g_last = jnp.exp(g[..., -1])

    def step(state, xs):
        u_c, w_c, qk_c, qd_c, kd_c, gl_c = xs
        v_new = u_c - w_c @ state
        o_c = qd_c @ state + qk_c @ v_new
        state = state * gl_c[..., None, None] + jnp.einsum("bhcd,bhce->bhde", kd_c, v_new)
        return state, o_c

    xs = tuple(jnp.moveaxis(t, 2, 0) for t in (u, w, qk, q_dec, k_dec, g_last))
    state0 = jnp.zeros((b_, h_, dk, dv), q.dtype)
    _, o = lax.scan(step, state0, xs)
    return jnp.moveaxis(o, 0, 2).reshape(b_, h_, s_, dv)


def gdn_mixer(q, k, v, z, a, b, conv_w, a_log, dt_bias, norm_g):
    b_, s_, _ = q.shape
    qkv = jax.nn.silu(causal_depthwise_conv(jnp.concatenate([q, k, v], axis=-1), conv_w))
    q, k, v = jnp.split(qkv.astype(jnp.float32), 3, axis=-1)
    heads = lambda t: t.reshape(b_, s_, GDN_HEADS, GDN_HEAD_DIM).transpose(0, 2, 1, 3)
    q = l2_normalize(heads(q)) * (GDN_HEAD_DIM ** -0.5)
    k = l2_normalize(heads(k))
    v = heads(v)
    beta = jax.nn.sigmoid(b.astype(jnp.float32)).transpose(0, 2, 1)
    g = -jnp.exp(a_log.astype(jnp.float32)) * jax.nn.softplus(
        a.astype(jnp.float32) + dt_bias.astype(jnp.float32))
    g = g.transpose(0, 2, 1)
    o = gated_delta_chunked(q, k, v, g, beta).transpose(0, 2, 1, 3)
    zf = z.astype(jnp.float32).reshape(b_, s_, GDN_HEADS, GDN_HEAD_DIM)
    o = o * lax.rsqrt(jnp.mean(o * o, axis=-1, keepdims=True) + EPS)
    o = o * norm_g.astype(jnp.float32) * jax.nn.silu(zf)
    return o.reshape(b_, s_, GDN_W).astype(q.dtype if False else z.dtype)


def dilated_branch(q, k, v, slopes, window, dilation):
    b_, h_, s_, dh = q.shape
    d = dilation
    n_back = window // dilation
    sub_len = s_ // d
    nb = -(-sub_len // SWA_BLOCK)
    lp = nb * SWA_BLOCK

    def gather_stride(t):
        t = t.reshape(b_, h_, sub_len, d, dh).transpose(0, 1, 3, 2, 4)
        return jnp.pad(t, ((0, 0), (0, 0), (0, 0), (0, lp - sub_len), (0, 0)))

    def kv_band(t):
        tb = t.reshape(b_, h_, d, nb, SWA_BLOCK, dh)
        prev = jnp.pad(tb, ((0, 0), (0, 0), (0, 0), (1, 0), (0, 0), (0, 0)))[:, :, :, :-1]
        return jnp.concatenate([prev, tb], axis=4)

    qb = gather_stride(q).reshape(b_, h_, d, nb, SWA_BLOCK, dh)
    kb = kv_band(gather_stride(k))
    vb = kv_band(gather_stride(v))
    s = jnp.einsum("bhrnqd,bhrnkd->bhrnqk", qb, kb) * (dh ** -0.5)
    p_idx = jnp.arange(SWA_BLOCK)
    c_idx = jnp.arange(2 * SWA_BLOCK)
    blk = jnp.arange(nb)
    delta = p_idx[:, None] + SWA_BLOCK - c_idx[None, :]
    key_pos = blk[:, None] * SWA_BLOCK + c_idx[None, :] - SWA_BLOCK
    valid = (delta >= 0)[None] & (delta <= n_back)[None] & (key_pos[:, None, :] >= 0)
    alibi = -slopes[:, None, None, None, None] * (dilation * delta).astype(jnp.float32)
    s = jnp.where(valid, s + alibi, -jnp.inf)
    m = jnp.max(s, axis=-1, keepdims=True)
    e = jnp.exp(s - m)
    l = jnp.sum(e, axis=-1, keepdims=True)
    o = jnp.einsum("bhrnqk,bhrnkd->bhrnqd", e, vb) / l
    lse = (m + jnp.log(l))[..., 0]
    o = o.reshape(b_, h_, d, lp, dh)[:, :, :, :sub_len].transpose(0, 1, 3, 2, 4).reshape(b_, h_, s_, dh)
    lse = lse.reshape(b_, h_, d, lp)[:, :, :, :sub_len].transpose(0, 1, 3, 2).reshape(b_, h_, s_)
    return o, lse


def dilated_mixer(q, k, v):
    b_, s_, _ = q.shape
    heads = lambda t: t.reshape(b_, s_, SWA_HEADS, SWA_HEAD_DIM).transpose(0, 2, 1, 3).astype(jnp.float32)
    qh, kh, vh = heads(q), heads(k), heads(v)
    slopes = 2.0 ** (-8.0 * jnp.arange(1, SWA_HEADS + 1, dtype=jnp.float32) / SWA_HEADS)
    outs, lses = [], []
    for window, dilation in DILATED_BRANCHES:
        o_i, lse_i = dilated_branch(qh, kh, vh, slopes, window, dilation)
        outs.append(o_i)
        lses.append(lse_i)
    wts = jax.nn.softmax(jnp.stack(lses, axis=0), axis=0)
    o = jnp.einsum("gbhs,gbhsd->bhsd", wts, jnp.stack(outs, axis=0))
    return o.transpose(0, 2, 1, 3).reshape(b_, s_, SWA_W).astype(q.dtype)


def memory_cross_attention(h, mem_n, wq, wk, wv, wo):
    b_, s_, _ = h.shape
    m_ = mem_n.shape[1]
    q = (h @ wq).reshape(b_, s_, MEM_HEADS, MEM_HEAD_DIM)
    k = (mem_n @ wk).reshape(b_, m_, MEM_HEADS, MEM_HEAD_DIM)
    v = (mem_n @ wv).reshape(b_, m_, MEM_HEADS, MEM_HEAD_DIM)
    s = jnp.einsum("bshd,bmhd->bhsm", q, k).astype(jnp.float32) * (MEM_HEAD_DIM ** -0.5)
    p = jax.nn.softmax(s, axis=-1).astype(v.dtype)
    o = jnp.einsum("bhsm,bmhd->bshd", p, v).reshape(b_, s_, D_MODEL)
    return o @ wo


def setup_inputs(seed: int = 0) -> dict:
    key = jax.random.key(seed)
    ks = iter(jax.random.split(key, 40))
    nrm = lambda shape, fan_in: jax.random.normal(next(ks), shape, jnp.float32) * (fan_in ** -0.5)
    gain = lambda n: 1.0 + 0.05 * jax.random.normal(next(ks), (DEPTH, n), jnp.float32)
    x = jax.random.normal(next(ks), (BATCH, SEQ, D_MODEL), jnp.float32)
    mem = jax.random.normal(next(ks), (BATCH, N_MEM, D_MODEL), jnp.float32)
    a_log = jnp.log(jax.random.uniform(next(ks), (DEPTH, GDN_HEADS), jnp.float32, 1.0, 16.0))
    dt = jnp.exp(jax.random.uniform(next(ks), (DEPTH, GDN_HEADS), jnp.float32,
                                    np.log(1e-3), np.log(1e-1)))
    dt_bias = dt + jnp.log(-jnp.expm1(-dt))
    return {
        "x": x,
        "mem": mem,
        "ffn1_pre_g": gain(D_MODEL),
        "ffn1_w_gate": nrm((DEPTH, D_MODEL, D_FF), D_MODEL),
        "ffn1_w_up": nrm((DEPTH, D_MODEL, D_FF), D_MODEL),
        "ffn1_w_down": nrm((DEPTH, D_FF, D_MODEL), D_FF),
        "ffn1_post_g": gain(D_MODEL),
        "mix_pre_g": gain(D_MODEL),
        "w_in": nrm((DEPTH, D_MODEL, IN_COLS), D_MODEL),
        "gdn_conv_w": nrm((DEPTH, GDN_CONV, 3 * GDN_W), GDN_CONV),
        "gdn_a_log": a_log,
        "gdn_dt_bias": dt_bias,
        "gdn_norm_g": gain(GDN_HEAD_DIM),
        "w_out": nrm((DEPTH, MIX_W, D_MODEL), MIX_W),
        "mix_post_g": gain(D_MODEL),
        "mem_pre_g": gain(D_MODEL),
        "mem_kv_g": gain(D_MODEL),
        "mem_wq": nrm((DEPTH, D_MODEL, D_MODEL), D_MODEL),
        "mem_wk": nrm((DEPTH, D_MODEL, D_MODEL), D_MODEL),
        "mem_wv": nrm((DEPTH, D_MODEL, D_MODEL), D_MODEL),
        "mem_wo": nrm((DEPTH, D_MODEL, D_MODEL), D_MODEL),
        "mem_post_g": gain(D_MODEL),
        "ffn2_pre_g": gain(D_MODEL),
        "ffn2_w_gate": nrm((DEPTH, D_MODEL, D_FF), D_MODEL),
        "ffn2_w_up": nrm((DEPTH, D_MODEL, D_FF), D_MODEL),
        "ffn2_w_down": nrm((DEPTH, D_FF, D_MODEL), D_FF),
        "ffn2_post_g": gain(D_MODEL),
    }


def reference(x, mem, ffn1_pre_g, ffn1_w_gate, ffn1_w_up, ffn1_w_down, ffn1_post_g,
              mix_pre_g, w_in, gdn_conv_w, gdn_a_log, gdn_dt_bias, gdn_norm_g, w_out, mix_post_g,
              mem_pre_g, mem_kv_g, mem_wq, mem_wk, mem_wv, mem_wo, mem_post_g,
              ffn2_pre_g, ffn2_w_gate, ffn2_w_up, ffn2_w_down, ffn2_post_g):
    for l in range(DEPTH):
        f = swiglu(rms_norm(x, ffn1_pre_g[l]), ffn1_w_gate[l], ffn1_w_up[l], ffn1_w_down[l])
        x = x + 0.5 * rms_norm(f, ffn1_post_g[l])
        h = rms_norm(x, mix_pre_g[l])
        proj = h @ w_in[l]
        qa, ka, va, za, aa, ba, qb, kb, vb = jnp.split(proj, IN_SPLITS, axis=-1)
        o_a = gdn_mixer(qa, ka, va, za, aa, ba, gdn_conv_w[l], gdn_a_log[l], gdn_dt_bias[l], gdn_norm_g[l])
        o_b = dilated_mixer(qb, kb, vb)
        mix = jnp.concatenate([o_a, o_b], axis=-1) @ w_out[l]
        x = x + rms_norm(mix, mix_post_g[l])
        c = memory_cross_attention(rms_norm(x, mem_pre_g[l]), rms_norm(mem, mem_kv_g[l]),
                                   mem_wq[l], mem_wk[l], mem_wv[l], mem_wo[l])
        x = x + rms_norm(c, mem_post_g[l])
        f = swiglu(rms_norm(x, ffn2_pre_g[l]), ffn2_w_gate[l], ffn2_w_up[l], ffn2_w_down[l])
        x = x + 0.5 * rms_norm(f, ffn2_post_g[l])
    return x
```

```cpp
#include <hip/hip_runtime.h>
#include <cstdio>
#include <cstdint>

namespace nv {
constexpr int D = 1024, NB = 8, SEQ = 2048, M = NB * SEQ, NMEM = 256, DFF = 2816, INC = 3592;
constexpr int GW = 512;
constexpr int RAWC = 2056;
constexpr float EPS = 1e-6f;

__device__ __forceinline__ float wave_sum(float v) {
#pragma unroll
    for (int o = 1; o < 64; o <<= 1) v += __shfl_xor(v, o);
    return v;
}
__device__ __forceinline__ float wave_max(float v) {
#pragma unroll
    for (int o = 1; o < 64; o <<= 1) v = fmaxf(v, __shfl_xor(v, o));
    return v;
}
__device__ __forceinline__ float silu_f(float x) { return x / (1.f + expf(-x)); }

__global__ void __launch_bounds__(256) k_rmsnorm(const float* __restrict__ x, const float* __restrict__ g, float* __restrict__ out, int rows) {
    const int w = (blockIdx.x * 256 + threadIdx.x) >> 6, lane = threadIdx.x & 63;
    if (w >= rows) return;
    const float4* xr = (const float4*)(x + (size_t)w * D);
    const float4* gr = (const float4*)g;
    float4 v[4]; float s = 0.f;
#pragma unroll
    for (int j = 0; j < 4; ++j) { v[j] = xr[lane + 64 * j]; s += v[j].x * v[j].x + v[j].y * v[j].y + v[j].z * v[j].z + v[j].w * v[j].w; }
    s = wave_sum(s);
    const float r = rsqrtf(s * (1.f / D) + EPS);
    float4* o = (float4*)(out + (size_t)w * D);
#pragma unroll
    for (int j = 0; j < 4; ++j) { const float4 gg = gr[lane + 64 * j]; float4 t; t.x = v[j].x * r * gg.x; t.y = v[j].y * r * gg.y; t.z = v[j].z * r * gg.z; t.w = v[j].w * r * gg.w; o[lane + 64 * j] = t; }
}
__global__ void __launch_bounds__(256) k_resnorm(const float* xin, const float* __restrict__ f, const float* __restrict__ g, float scale, float* xout, int rows) {
    const int w = (blockIdx.x * 256 + threadIdx.x) >> 6, lane = threadIdx.x & 63;
    if (w >= rows) return;
    const float4* fr = (const float4*)(f + (size_t)w * D);
    const float4* xr = (const float4*)(xin + (size_t)w * D);
    const float4* gr = (const float4*)g;
    float4 v[4]; float s = 0.f;
#pragma unroll
    for (int j = 0; j < 4; ++j) { v[j] = fr[lane + 64 * j]; s += v[j].x * v[j].x + v[j].y * v[j].y + v[j].z * v[j].z + v[j].w * v[j].w; }
    s = wave_sum(s);
    const float r = rsqrtf(s * (1.f / D) + EPS) * scale;
    float4* o = (float4*)(xout + (size_t)w * D);
#pragma unroll
    for (int j = 0; j < 4; ++j) { const float4 gg = gr[lane + 64 * j]; const float4 xx = xr[lane + 64 * j]; float4 t;
        t.x = xx.x + v[j].x * r * gg.x; t.y = xx.y + v[j].y * r * gg.y; t.z = xx.z + v[j].z * r * gg.z; t.w = xx.w + v[j].w * r * gg.w; o[lane + 64 * j] = t; }
}
__global__ void __launch_bounds__(256) k_gemm(const float* __restrict__ A, int lda, const float* __restrict__ Bm, int ldb, float* __restrict__ C, int ldc, int Mr, int N, int K) {
    __shared__ float As[16][68];
    __shared__ float Bs[16][68];
    const int t = threadIdx.x, tx = t & 15, ty = t >> 4;
    const int m0 = blockIdx.y * 64, n0 = blockIdx.x * 64;
    float acc[4][4];
#pragma unroll
    for (int i = 0; i < 4; ++i)
#pragma unroll
        for (int j = 0; j < 4; ++j) acc[i][j] = 0.f;
    const int ar = t >> 2, ak = (t & 3) * 4;
    const int bk = t >> 4, bn = (t & 15) * 4;
    const bool bok = (n0 + bn) < N;
    for (int k0 = 0; k0 < K; k0 += 16) {
        const float4 a = *(const float4*)(A + (size_t)(m0 + ar) * lda + k0 + ak);
        float4 b = make_float4(0.f, 0.f, 0.f, 0.f);
        if (bok) b = *(const float4*)(Bm + (size_t)(k0 + bk) * ldb + n0 + bn);
        As[ak + 0][ar] = a.x; As[ak + 1][ar] = a.y; As[ak + 2][ar] = a.z; As[ak + 3][ar] = a.w;
        *(float4*)&Bs[bk][bn] = b;
        __syncthreads();
#pragma unroll
        for (int kk = 0; kk < 16; ++kk) {
            const float4 av = *(const float4*)&As[kk][ty * 4];
            const float4 bv = *(const float4*)&Bs[kk][tx * 4];
            const float aa[4] = {av.x, av.y, av.z, av.w};
            const float bb[4] = {bv.x, bv.y, bv.z, bv.w};
#pragma unroll
            for (int i = 0; i < 4; ++i)
#pragma unroll
                for (int j = 0; j < 4; ++j) acc[i][j] = fmaf(aa[i], bb[j], acc[i][j]);
        }
        __syncthreads();
    }
    if ((n0 + tx * 4) < N) {
#pragma unroll
        for (int i = 0; i < 4; ++i) *(float4*)(C + (size_t)(m0 + ty * 4 + i) * ldc + n0 + tx * 4) = make_float4(acc[i][0], acc[i][1], acc[i][2], acc[i][3]);
    }
}
__global__ void __launch_bounds__(256) k_silu_mul(float* __restrict__ g, const float* __restrict__ u, size_t n4) {
    const size_t i = (size_t)blockIdx.x * 256 + threadIdx.x;
    if (i >= n4) return;
    float4 a = ((float4*)g)[i]; const float4 b = ((const float4*)u)[i];
    a.x = silu_f(a.x) * b.x; a.y = silu_f(a.y) * b.y; a.z = silu_f(a.z) * b.z; a.w = silu_f(a.w) * b.w;
    ((float4*)g)[i] = a;
}
__global__ void __launch_bounds__(256) k_gdn_prep(const float* __restrict__ raw, const float* __restrict__ convw, const float* __restrict__ a_log, const float* __restrict__ dt_bias,
                                                  float* __restrict__ QN, float* __restrict__ KN, float* __restrict__ VV, float* __restrict__ MIX, float* __restrict__ BETA, float* __restrict__ GG, int row0) {
    const int t = blockIdx.x, h = threadIdx.x >> 6, lane = threadIdx.x & 63;
    float qv[2], kv[2], vv[2];
#pragma unroll
    for (int e = 0; e < 2; ++e) {
        const int c = h * 128 + lane + 64 * e;
        float yq = 0.f, yk = 0.f, yv = 0.f;
#pragma unroll
        for (int j = 0; j < 4; ++j) {
            const int tt = t - 3 + j;
            if (tt >= 0) {
                const float* r = raw + (size_t)tt * RAWC;
                yq += convw[j * 1536 + c] * r[c];
                yk += convw[j * 1536 + 512 + c] * r[512 + c];
                yv += convw[j * 1536 + 1024 + c] * r[1024 + c];
            }
        }
        qv[e] = silu_f(yq); kv[e] = silu_f(yk); vv[e] = silu_f(yv);
    }
    const float sq = wave_sum(qv[0] * qv[0] + qv[1] * qv[1]);
    const float sk = wave_sum(kv[0] * kv[0] + kv[1] * kv[1]);
    const float rq = rsqrtf(sq + EPS) * 0.08838834764831845f;
    const float rk = rsqrtf(sk + EPS);
    const size_t row = (size_t)row0 + t;
#pragma unroll
    for (int e = 0; e < 2; ++e) {
        const int c = h * 128 + lane + 64 * e;
        QN[row * GW + c] = qv[e] * rq; KN[row * GW + c] = kv[e] * rk; VV[row * GW + c] = vv[e];
        MIX[row * D + c] = raw[(size_t)t * RAWC + 1536 + c];
    }
    if (lane == 0) {
        const float a = raw[(size_t)t * RAWC + 2048 + h], bb = raw[(size_t)t * RAWC + 2052 + h];
        BETA[row * 4 + h] = 1.f / (1.f + expf(-bb));
        const float xx = a + dt_bias[h];
        const float sp = (xx > 20.f) ? xx : log1pf(expf(xx));
        GG[row * 4 + h] = -expf(a_log[h]) * sp;
    }
}
__global__ void __launch_bounds__(256) k_gdn_rec(const float* __restrict__ QN, const float* __restrict__ KN, float* VV, const float* __restrict__ BETA, const float* __restrict__ GG) {
    __shared__ float ks[128], qs[128], red[8][32];
    const int bh = blockIdx.x >> 2, sl = blockIdx.x & 3, b = bh >> 2, h = bh & 3;
    const int tid = threadIdx.x, col = tid & 31, grp = tid >> 5;
    float S[16];
#pragma unroll
    for (int i = 0; i < 16; ++i) S[i] = 0.f;
    for (int t = 0; t < SEQ; ++t) {
        const size_t row = (size_t)b * SEQ + t;
        if (tid < 128) ks[tid] = KN[row * GW + h * 128 + tid]; else qs[tid - 128] = QN[row * GW + h * 128 + tid - 128];
        const float vt = VV[row * GW + h * 128 + sl * 32 + col];
        const float bt = BETA[row * 4 + h];
        const float eg = expf(GG[row * 4 + h]);
        __syncthreads();
        float p = 0.f;
#pragma unroll
        for (int i = 0; i < 16; ++i) p = fmaf(ks[grp * 16 + i], S[i], p);
        red[grp][col] = p;
        __syncthreads();
        float kS = 0.f;
#pragma unroll
        for (int g2 = 0; g2 < 8; ++g2) kS += red[g2][col];
        __syncthreads();
        float o = 0.f;
#pragma unroll
        for (int i = 0; i < 16; ++i) { const float kk = ks[grp * 16 + i]; S[i] = eg * (S[i] - bt * kk * kS) + bt * kk * vt; o = fmaf(S[i], qs[grp * 16 + i], o); }
        red[grp][col] = o;
        __syncthreads();
        if (grp == 0) { float os = 0.f;
#pragma unroll
            for (int g2 = 0; g2 < 8; ++g2) os += red[g2][col];
            VV[row * GW + h * 128 + sl * 32 + col] = os; }
        __syncthreads();
    }
}
__global__ void __launch_bounds__(256) k_gdn_gate(const float* __restrict__ O, const float* __restrict__ ng, float* MIX) {
    const size_t row = blockIdx.x; const int h = threadIdx.x >> 6, lane = threadIdx.x & 63;
    float o[2];
#pragma unroll
    for (int e = 0; e < 2; ++e) o[e] = O[row * GW + h * 128 + lane + 64 * e];
    const float ss = wave_sum(o[0] * o[0] + o[1] * o[1]);
    const float r = rsqrtf(ss * (1.f / 128.f) + EPS);
#pragma unroll
    for (int e = 0; e < 2; ++e) { const int d = lane + 64 * e; const float z = MIX[row * D + h * 128 + d]; MIX[row * D + h * 128 + d] = o[e] * r * ng[d] * silu_f(z); }
}
__global__ void __launch_bounds__(256) k_swa(const float* __restrict__ QKV, float* __restrict__ MIX) {
    const int idx = blockIdx.x * 256 + threadIdx.x;
    const int t = idx % SEQ, h = (idx / SEQ) % 8, b = idx / (SEQ * 8);
    const float slope = exp2f(-(float)(h + 1));
    const float* base = QKV + (size_t)b * SEQ * 1536;
    float q[64], o[64];
    { const float4* qp = (const float4*)(base + (size_t)t * 1536 + h * 64);
#pragma unroll
      for (int i = 0; i < 16; ++i) { const float4 v = qp[i]; q[4 * i] = v.x; q[4 * i + 1] = v.y; q[4 * i + 2] = v.z; q[4 * i + 3] = v.w; } }
#pragma unroll
    for (int i = 0; i < 64; ++i) o[i] = 0.f;
    float m = -INFINITY, l = 0.f;
    for (int br = 0; br < 3; ++br) {
        const int dil = (br == 0) ? 1 : (br == 1 ? 4 : 16);
        for (int dl = 0; dl <= 128; ++dl) {
            const int tk = t - dl * dil;
            if (tk < 0) break;
            const float4* kp = (const float4*)(base + (size_t)tk * 1536 + 512 + h * 64);
            float s = 0.f;
#pragma unroll
            for (int i = 0; i < 16; ++i) { const float4 v = kp[i]; s = fmaf(q[4 * i], v.x, s); s = fmaf(q[4 * i + 1], v.y, s); s = fmaf(q[4 * i + 2], v.z, s); s = fmaf(q[4 * i + 3], v.w, s); }
            s = s * 0.125f - slope * (float)(dil * dl);
            const float mn = fmaxf(m, s);
            const float c = expf(m - mn), p = expf(s - mn);
            l = l * c + p; m = mn;
            const float4* vp = (const float4*)(base + (size_t)tk * 1536 + 1024 + h * 64);
#pragma unroll
            for (int i = 0; i < 16; ++i) { const float4 v = vp[i]; o[4 * i] = o[4 * i] * c + p * v.x; o[4 * i + 1] = o[4 * i + 1] * c + p * v.y; o[4 * i + 2] = o[4 * i + 2] * c + p * v.z; o[4 * i + 3] = o[4 * i + 3] * c + p * v.w; }
        }
    }
    const float il = 1.f / l;
    float4* op = (float4*)(MIX + ((size_t)b * SEQ + t) * D + 512 + h * 64);
#pragma unroll
    for (int i = 0; i < 16; ++i) op[i] = make_float4(o[4 * i] * il, o[4 * i + 1] * il, o[4 * i + 2] * il, o[4 * i + 3] * il);
}
__global__ void __launch_bounds__(256) k_xattn(const float* __restrict__ Q, const float* __restrict__ KM, const float* __restrict__ VM, float* __restrict__ O) {
    __shared__ float qs[1024];
    __shared__ float ps[4][256];
    const size_t row = blockIdx.x; const int b = (int)(row / SEQ);
    const int tid = threadIdx.x, w = tid >> 6, lane = tid & 63;
    *(float4*)&qs[tid * 4] = *(const float4*)(Q + row * D + tid * 4);
    __syncthreads();
    float sc[4];
#pragma unroll
    for (int i = 0; i < 4; ++i) {
        const int mk = lane + 64 * i;
        const float4* kp = (const float4*)(KM + ((size_t)b * NMEM + mk) * D + w * 256);
        float s = 0.f;
        for (int d4 = 0; d4 < 64; ++d4) { const float4 kv = kp[d4]; const float4 qv = *(const float4*)&qs[w * 256 + d4 * 4]; s = fmaf(qv.x, kv.x, s); s = fmaf(qv.y, kv.y, s); s = fmaf(qv.z, kv.z, s); s = fmaf(qv.w, kv.w, s); }
        sc[i] = s * 0.0625f;
    }
    const float mx = wave_max(fmaxf(fmaxf(sc[0], sc[1]), fmaxf(sc[2], sc[3])));
    float e[4]; float sum = 0.f;
#pragma unroll
    for (int i = 0; i < 4; ++i) { e[i] = expf(sc[i] - mx); sum += e[i]; }
    sum = wave_sum(sum);
    const float inv = 1.f / sum;
#pragma unroll
    for (int i = 0; i < 4; ++i) ps[w][lane + 64 * i] = e[i] * inv;
    __syncthreads();
    float4 acc = make_float4(0.f, 0.f, 0.f, 0.f);
    for (int mk = 0; mk < NMEM; ++mk) {
        const float p = ps[w][mk];
        const float4 v = *(const float4*)(VM + ((size_t)b * NMEM + mk) * D + w * 256 + lane * 4);
        acc.x = fmaf(p, v.x, acc.x); acc.y = fmaf(p, v.y, acc.y); acc.z = fmaf(p, v.z, acc.z); acc.w = fmaf(p, v.w, acc.w);
    }
    *(float4*)(O + row * D + w * 256 + lane * 4) = acc;
}

static void gemm(hipStream_t st, const float* A, int lda, const float* Bm, int ldb, float* C, int ldc, int Mr, int N, int K) {
    dim3 grid((N + 63) / 64, Mr / 64);
    hipLaunchKernelGGL(k_gemm, grid, dim3(256), 0, st, A, lda, Bm, ldb, C, ldc, Mr, N, K);
}
static void ffn(hipStream_t st, const float* HN, const float* wg, const float* wu, const float* wd, float* T1, float* SCR) {
    constexpr int RC = 2048;
    float* G = SCR; float* U = SCR + (size_t)RC * DFF;
    for (int c = 0; c < M / RC; ++c) {
        const float* a = HN + (size_t)c * RC * D;
        gemm(st, a, D, wg, DFF, G, DFF, RC, DFF, D);
        gemm(st, a, D, wu, DFF, U, DFF, RC, DFF, D);
        const size_t n4 = (size_t)RC * DFF / 4;
        hipLaunchKernelGGL(k_silu_mul, dim3((unsigned)((n4 + 255) / 256)), dim3(256), 0, st, G, U, n4);
        gemm(st, G, DFF, wd, D, T1 + (size_t)c * RC * D, D, RC, D, DFF);
    }
}
}

extern "C" void kernel_launch(void* const* d_in, const int* in_sizes, int n_in, void* d_out, int out_size, void* d_ws, size_t ws_size, hipStream_t stream) {
    using namespace nv;
    const float* x = (const float*)d_in[0]; const float* mem = (const float*)d_in[1];
    const float* f1_pre = (const float*)d_in[2]; const float* f1_wg = (const float*)d_in[3]; const float* f1_wu = (const float*)d_in[4]; const float* f1_wd = (const float*)d_in[5]; const float* f1_post = (const float*)d_in[6];
    const float* mix_pre = (const float*)d_in[7]; const float* w_in = (const float*)d_in[8]; const float* conv_w = (const float*)d_in[9]; const float* a_log = (const float*)d_in[10];
    const float* dt_bias = (const float*)d_in[11]; const float* norm_g = (const float*)d_in[12]; const float* w_out = (const float*)d_in[13]; const float* mix_post = (const float*)d_in[14];
    const float* mem_pre = (const float*)d_in[15]; const float* mem_kv_g = (const float*)d_in[16]; const float* wq = (const float*)d_in[17]; const float* wk = (const float*)d_in[18];
    const float* wv = (const float*)d_in[19]; const float* wo = (const float*)d_in[20]; const float* mem_post = (const float*)d_in[21];
    const float* f2_pre = (const float*)d_in[22]; const float* f2_wg = (const float*)d_in[23]; const float* f2_wu = (const float*)d_in[24]; const float* f2_wd = (const float*)d_in[25]; const float* f2_post = (const float*)d_in[26];
    float* XA = (float*)d_out;
    const size_t MiBf = (1u << 20) / 4;
    float* ws = (float*)d_ws;
    float* HN = ws; float* MIX = ws + 64 * MiBf; float* R = ws + 128 * MiBf;
    float* T1 = R; float* SCR = R + 64 * MiBf;
    float* QN = R; float* KN = R + 32 * MiBf; float* VV = R + 64 * MiBf; float* RAW = R + 96 * MiBf; float* BETA = R + 116 * MiBf; float* GG = R + 117 * MiBf;
    const int nrb = M / 4;

    hipLaunchKernelGGL(k_rmsnorm, dim3(nrb), dim3(256), 0, stream, x, f1_pre, HN, M);
    ffn(stream, HN, f1_wg, f1_wu, f1_wd, T1, SCR);
    hipLaunchKernelGGL(k_resnorm, dim3(nrb), dim3(256), 0, stream, x, T1, f1_post, 0.5f, XA, M);
    hipLaunchKernelGGL(k_rmsnorm, dim3(nrb), dim3(256), 0, stream, XA, mix_pre, HN, M);
    for (int b = 0; b < NB; ++b) {
        gemm(stream, HN + (size_t)b * SEQ * D, D, w_in, INC, RAW, RAWC, SEQ, RAWC, D);
        hipLaunchKernelGGL(k_gdn_prep, dim3(SEQ), dim3(256), 0, stream, RAW, conv_w, a_log, dt_bias, QN, KN, VV, MIX, BETA, GG, b * SEQ);
    }
    hipLaunchKernelGGL(k_gdn_rec, dim3(NB * 4 * 4), dim3(256), 0, stream, QN, KN, VV, BETA, GG);
    hipLaunchKernelGGL(k_gdn_gate, dim3(M), dim3(256), 0, stream, VV, norm_g, MIX);
    gemm(stream, HN, D, w_in + RAWC, INC, R, 1536, M, 1536, D);
    hipLaunchKernelGGL(k_swa, dim3(M * 8 / 256), dim3(256), 0, stream, R, MIX);
    gemm(stream, MIX, D, w_out, D, T1, D, M, D, D);
    hipLaunchKernelGGL(k_resnorm, dim3(nrb), dim3(256), 0, stream, XA, T1, mix_post, 1.0f, XA, M);
    hipLaunchKernelGGL(k_rmsnorm, dim3(nrb), dim3(256), 0, stream, XA, mem_pre, HN, M);
    float* MEMN = SCR; float* KM = SCR + 8 * MiBf; float* VM = SCR + 16 * MiBf;
    hipLaunchKernelGGL(k_rmsnorm, dim3(NB * NMEM / 4), dim3(256), 0, stream, mem, mem_kv_g, MEMN, NB * NMEM);
    gemm(stream, MEMN, D, wk, D, KM, D, NB * NMEM, D, D);
    gemm(stream, MEMN, D, wv, D, VM, D, NB * NMEM, D, D);
    gemm(stream, HN, D, wq, D, MIX, D, M, D, D);
    hipLaunchKernelGGL(k_xattn, dim3(M), dim3(256), 0, stream, MIX, KM, VM, HN);
    gemm(stream, HN, D, wo, D, T1, D, M, D, D);
    hipLaunchKernelGGL(k_resnorm, dim3(nrb), dim3(256), 0, stream, XA, T1, mem_post, 1.0f, XA, M);
    hipLaunchKernelGGL(k_rmsnorm, dim3(nrb), dim3(256), 0, stream, XA, f2_pre, HN, M);
    ffn(stream, HN, f2_wg, f2_wu, f2_wd, T1, SCR);
    hipLaunchKernelGGL(k_resnorm, dim3(nrb), dim3(256), 0, stream, XA, T1, f2_post, 0.5f, XA, M);
}
```

```cpp
#include <hip/hip_runtime.h>
#include <cstdio>
#include <cstdint>
#include <cmath>
namespace pg8 {
#define PG8_LAS __attribute__((address_space(3)))
typedef unsigned short bf16_t;
typedef short bf16x8 __attribute__((ext_vector_type(8)));
typedef float f32x4 __attribute__((ext_vector_type(4)));
typedef unsigned u32x4 __attribute__((ext_vector_type(4)));
constexpr int BM = 256, BK = 64, HALF = 128, HTB = HALF * BK * 2  , STAGE_BYTES = 8 * HTB, NXCD = 8, WGM = 8;
__host__ __device__ __forceinline__ int lds_byte(int r, int c) { const int st = (r >> 4) * 2 + (c >> 5), rr = r & 15, cc = c & 31, ob = rr * 64 + cc * 2; return st * 1024 + (ob ^ (((ob >> 9) & 1) << 5)); }
__host__ __device__ __forceinline__ void stage_rc(int b, int& R, int& C) { const int st = b / 1024, sb = b % 1024, swz = sb ^ (((sb >> 9) & 1) << 5); R = (st >> 1) * 16 + swz / 64; C = (st & 1) * 32 + (swz % 64) / 2; }
__host__ __device__ __forceinline__ int perm32(int rho) { const int n = rho >> 4, i = rho & 15; return 8 * (i >> 2) + 4 * n + (i & 3); }
struct Unit { int pm, pn; };
struct Gemm { const bf16_t* A; const bf16_t* Bt; int M, N, K, lda; };

struct StaticOrder {
    int nM, nN, nwg, G, c;
    __host__ __device__ void init(int M, int N, int G_, int c_) { nM = M / BM; nN = N / BM; nwg = nM * nN; G = G_; c = c_; }
    __host__ __device__ bool next(int i, Unit& u) const {
        const long L = (long)i * G + c; if (L >= nwg) return false;
        int wgid = (int)L; { const int q = nwg / NXCD, r = nwg % NXCD, xcd = wgid % NXCD, off = wgid / NXCD; wgid = (xcd < r ? xcd * (q + 1) : r * (q + 1) + (xcd - r) * q) + off; }
        const int nig = WGM * nN, gid = wgid / nig, fm = gid * WGM, gsz = (nM - fm) < WGM ? (nM - fm) : WGM;
        u.pm = fm + ((wgid % nig) % gsz); u.pn = (wgid % nig) / gsz; return true;
    }
    __device__ __forceinline__ void a_ready(const Unit&) const {}
    __device__ __forceinline__ void done(const Unit&) const {}
};
struct ProjKvOrder {
    StaticOrder so; int G, c;
    __host__ __device__ void init(int G_, int c_) { so.init(16384, 3840, G_, c_); G = G_; c = c_; }
    __host__ __device__ bool next(int i, Unit& u) const {
        if (so.next(i, u)) return true;
        const long kv = (long)i * G + c - so.nwg; if (kv < 0 || kv >= 64) return false;
        u.pm = 64 + (int)(kv & 7); u.pn = 15 + (int)(kv >> 3); return true;
    }
    __device__ __forceinline__ void a_ready(const Unit&) const {}
    __device__ __forceinline__ void done(const Unit&) const {}
};

__device__ __forceinline__ unsigned cvt_pk_bf16(float lo, float hi) { unsigned r; asm volatile("v_cvt_pk_bf16_f32 %0, %1, %2" : "=v"(r) : "v"(lo), "v"(hi)); return r; }
__device__ __forceinline__ float fast_silu(float x) { return x * __builtin_amdgcn_rcpf(1.0f + __builtin_amdgcn_exp2f(-1.4426950408889634f * x)); }
__device__ __forceinline__ u32x4 pack8(const f32x4 a, const f32x4 b) { u32x4 w; w.x = cvt_pk_bf16(a[0], a[1]); w.y = cvt_pk_bf16(a[2], a[3]); w.z = cvt_pk_bf16(b[0], b[1]); w.w = cvt_pk_bf16(b[2], b[3]); return w; }

struct EpiBf16 {
    static constexpr bool PERM = true, AFTER_DRAIN = false;
    bf16_t* O; int ldc;
    __device__ __forceinline__ void operator()(const f32x4 (&acc)[2][2][4][2], const Unit& u, int wr, int wc, int fr, int fq) const {
        const int row0 = u.pm * BM + wr * 64 + fr, col0 = u.pn * BM + wc * 32 + 8 * fq;
#pragma unroll
        for (int ai = 0; ai < 2; ++ai)
#pragma unroll
            for (int m = 0; m < 4; ++m) { bf16_t* rowp = O + (size_t)(row0 + ai * HALF + m * 16) * ldc + col0;
#pragma unroll
                for (int bj = 0; bj < 2; ++bj) *(u32x4*)(rowp + bj * HALF) = pack8(acc[ai][bj][m][0], acc[ai][bj][m][1]); }
    }
};
struct EpiSwiglu {
    static constexpr bool PERM = true, AFTER_DRAIN = false;
    bf16_t* O; int ldc;
    __device__ __forceinline__ void operator()(const f32x4 (&acc)[2][2][4][2], const Unit& u, int wr, int wc, int fr, int fq) const {
        const int row0 = u.pm * BM + wr * 64 + fr, col0 = u.pn * HALF + wc * 32 + 8 * fq;
#pragma unroll
        for (int ai = 0; ai < 2; ++ai)
#pragma unroll
            for (int m = 0; m < 4; ++m) { bf16_t* rowp = O + (size_t)(row0 + ai * HALF + m * 16) * ldc + col0;
                f32x4 h0, h1;
#pragma unroll
                for (int e = 0; e < 4; ++e) { h0[e] = fast_silu(acc[ai][0][m][0][e]) * acc[ai][1][m][0][e]; h1[e] = fast_silu(acc[ai][0][m][1][e]) * acc[ai][1][m][1][e]; }
                *(u32x4*)rowp = pack8(h0, h1); }
    }
};
struct EpiProjKv {
    static constexpr bool PERM = true, AFTER_DRAIN = false;
    bf16_t* P; float* AB; bf16_t* KM; bf16_t* VM;
    __device__ __forceinline__ void operator()(const f32x4 (&acc)[2][2][4][2], const Unit& u, int wr, int wc, int fr, int fq) const {
        if (u.pn < 14) {
            const int row0 = u.pm * BM + wr * 64 + fr, col0 = u.pn * BM + wc * 32 + 8 * fq;
#pragma unroll
            for (int ai = 0; ai < 2; ++ai)
#pragma unroll
                for (int m = 0; m < 4; ++m) { bf16_t* rowp = P + (size_t)(row0 + ai * HALF + m * 16) * 3584 + col0;
#pragma unroll
                    for (int bj = 0; bj < 2; ++bj) *(u32x4*)(rowp + bj * HALF) = pack8(acc[ai][bj][m][0], acc[ai][bj][m][1]); }
        } else if (u.pn == 14) {
            if (wc == 0 && fq == 0) {
                const int row0 = u.pm * BM + wr * 64 + fr;
#pragma unroll
                for (int ai = 0; ai < 2; ++ai)
#pragma unroll
                    for (int m = 0; m < 4; ++m) { float* rowp = AB + (size_t)(row0 + ai * HALF + m * 16) * 8; *(f32x4*)rowp = acc[ai][0][m][0]; *(f32x4*)(rowp + 4) = acc[ai][0][m][1]; }
            }
        } else {
            const int row0 = (u.pm - 64) * BM + wr * 64 + fr; int ct = (u.pn - 15) * BM; bf16_t* base = KM; if (ct >= 1024) { ct -= 1024; base = VM; }
            const int col0 = ct + wc * 32 + 8 * fq;
#pragma unroll
            for (int ai = 0; ai < 2; ++ai)
#pragma unroll
                for (int m = 0; m < 4; ++m) { bf16_t* rowp = base + (size_t)(row0 + ai * HALF + m * 16) * 1024 + col0;
#pragma unroll
                    for (int bj = 0; bj < 2; ++bj) *(u32x4*)(rowp + bj * HALF) = pack8(acc[ai][bj][m][0], acc[ai][bj][m][1]); }
        }
    }
};

template <class Epi, class Sched, bool ALIGN_EPI = false, bool SP2 = false>
__device__ __forceinline__ void gemm_phase(PG8_LAS unsigned char* lds, const Gemm g, const Sched& S, const Epi& E) {
    const int tid = threadIdx.x, wid = __builtin_amdgcn_readfirstlane(tid >> 6), lane = tid & 63, wr = wid >> 2, wc = wid & 3, fr = lane & 15, fq = lane >> 4;
    const int K = g.K, nt = K / BK;
    unsigned voffA[2], voffB[2];
#pragma unroll
    for (int i = 0; i < 2; ++i) { int R, C; stage_rc(tid * 16 + i * 8192, R, C); const int Rb = Epi::PERM ? ((R & ~31) + perm32(R & 31)) : R;
        voffA[i] = (unsigned)(R * g.lda + C) * 2u; voffB[i] = (unsigned)(Rb * K + C) * 2u; }
    const size_t kstep = (size_t)(BK * 2);
    const size_t hstepA = (size_t)HALF * g.lda * 2, hstepB = (size_t)HALF * K * 2;
    const size_t tstepA = 2 * hstepA, tstepB = 2 * hstepB;
    const unsigned ldsw = (unsigned)wid * 1024u;
    const int aoff = lds_byte(wr * 64 + fr, fq * 8), boff = lds_byte(wc * 32 + fr, fq * 8);
#define PG8_SA(b, h) (((b) * 2 + (h)) * HTB)
#define PG8_SB(b, h) ((4 + (b) * 2 + (h)) * HTB)
#define PG8_STAGE(bufoff, gbase, voff) do { _Pragma("unroll") for (int _i = 0; _i < 2; ++_i) \
        __builtin_amdgcn_global_load_lds((const unsigned*)((const char*)(gbase) + (voff)[_i]), (PG8_LAS unsigned*)(lds + (bufoff) + ldsw + _i * 8192), 16, 0, 0); } while (0)
#define PG8_LDA(dst, b, h) do { _Pragma("unroll") for (int m = 0; m < 4; ++m) _Pragma("unroll") for (int k = 0; k < 2; ++k) dst[m][k] = *(const PG8_LAS bf16x8*)(lds + PG8_SA(b, h) + aoff + m * 2048 + k * 1024); } while (0)
#define PG8_LDB(dst, b, h) do { _Pragma("unroll") for (int n = 0; n < 2; ++n) _Pragma("unroll") for (int k = 0; k < 2; ++k) dst[n][k] = *(const PG8_LAS bf16x8*)(lds + PG8_SB(b, h) + boff + n * 2048 + k * 1024); } while (0)
#define PG8_MMA(ai, bj, At, Bt) do { __builtin_amdgcn_s_setprio(1); _Pragma("unroll") for (int m = 0; m < 4; ++m) _Pragma("unroll") for (int n = 0; n < 2; ++n) _Pragma("unroll") for (int k = 0; k < 2; ++k) \
        acc[ai][bj][m][n] = __builtin_amdgcn_mfma_f32_16x16x32_bf16(Bt[n][k], At[m][k], acc[ai][bj][m][n], 0, 0, 0); __builtin_amdgcn_s_setprio(0); } while (0)
#define PG8_WAIT_V(n) asm volatile("s_waitcnt vmcnt(" #n ")" ::: "memory")
#define PG8_WAIT_L(n) asm volatile("s_waitcnt lgkmcnt(" #n ")" ::: "memory")
#define PG8_BAR __builtin_amdgcn_s_barrier()
#define PG8_SCHED __builtin_amdgcn_sched_barrier(0)
    Unit cur, nxt; int ui = 0;
    if (!S.next(0, cur)) return;
    f32x4 acc[2][2][4][2];
#pragma unroll
    for (int a = 0; a < 2; ++a)
#pragma unroll
        for (int b = 0; b < 2; ++b)
#pragma unroll
            for (int m = 0; m < 4; ++m)
#pragma unroll
                for (int n = 0; n < 2; ++n) acc[a][b][m][n] = (f32x4){0.f, 0.f, 0.f, 0.f};
    bf16x8 At[4][2], B0[2][2], B1[2][2];
    const char* cA = (const char*)g.A + (size_t)cur.pm * tstepA; const char* cB = (const char*)g.Bt + (size_t)cur.pn * tstepB;
    S.a_ready(cur);
    if constexpr (SP2) {
        PG8_STAGE(PG8_SB(0, 0), cB, voffB); PG8_STAGE(PG8_SB(0, 1), cB + hstepB, voffB); PG8_STAGE(PG8_SA(0, 0), cA, voffA); PG8_STAGE(PG8_SA(0, 1), cA + hstepA, voffA);
        if (wr == 1) PG8_BAR;
        PG8_WAIT_V(2); PG8_BAR;
        PG8_STAGE(PG8_SB(1, 0), cB + kstep, voffB); PG8_STAGE(PG8_SA(1, 0), cA + kstep, voffA); PG8_STAGE(PG8_SB(1, 1), cB + hstepB + kstep, voffB);
        PG8_WAIT_V(6); PG8_BAR;
    } else {
        PG8_STAGE(PG8_SB(0, 0), cB, voffB); PG8_STAGE(PG8_SA(0, 0), cA, voffA); PG8_STAGE(PG8_SB(0, 1), cB + hstepB, voffB); PG8_STAGE(PG8_SA(0, 1), cA + hstepA, voffA);
        if (wr == 1) PG8_BAR;
        PG8_WAIT_V(4); PG8_BAR;
        PG8_STAGE(PG8_SB(1, 0), cB + kstep, voffB); PG8_STAGE(PG8_SA(1, 0), cA + kstep, voffA); PG8_STAGE(PG8_SB(1, 1), cB + hstepB + kstep, voffB);
        PG8_WAIT_V(6); PG8_BAR;
    }
    for (;;) {
        const bool has_next = S.next(ui + 1, nxt);
        const char* nA = has_next ? (const char*)g.A + (size_t)nxt.pm * tstepA : cA; const char* nB = has_next ? (const char*)g.Bt + (size_t)nxt.pn * tstepB : cB;
        for (int t = 0; t < nt; t += 2) {
            const bool last = (t == nt - 2);
            const char* a1 = cA + (size_t)(t + 1) * kstep;
            const char* a2 = last ? nA : cA + (size_t)(t + 2) * kstep; const char* b2 = last ? nB : cB + (size_t)(t + 2) * kstep;
            const char* a3 = a2 + kstep; const char* b3 = b2 + kstep;
            if (last && has_next) S.a_ready(nxt);
            if constexpr (SP2) {
            PG8_LDB(B0, 0, 0); PG8_LDB(B1, 0, 1); PG8_SCHED; PG8_LDA(At, 0, 0); PG8_STAGE(PG8_SA(1, 1), a1 + hstepA, voffA);
            PG8_WAIT_V(8); PG8_WAIT_L(0); PG8_BAR; PG8_MMA(0, 0, At, B0); PG8_MMA(0, 1, At, B1); PG8_BAR; PG8_SCHED;
            PG8_LDA(At, 0, 1); PG8_STAGE(PG8_SB(0, 0), b2, voffB); PG8_STAGE(PG8_SB(0, 1), b2 + hstepB, voffB); PG8_STAGE(PG8_SA(0, 0), a2, voffA);
            PG8_WAIT_V(8); PG8_WAIT_L(0); PG8_BAR; PG8_MMA(1, 0, At, B0); PG8_MMA(1, 1, At, B1); PG8_BAR; PG8_SCHED;
            PG8_LDB(B0, 1, 0); PG8_LDB(B1, 1, 1); PG8_SCHED; PG8_LDA(At, 1, 0); PG8_STAGE(PG8_SA(0, 1), a2 + hstepA, voffA);
            PG8_WAIT_V(8); PG8_WAIT_L(0); PG8_BAR; PG8_MMA(0, 0, At, B0); PG8_MMA(0, 1, At, B1); PG8_BAR; PG8_SCHED;
            PG8_LDA(At, 1, 1); PG8_STAGE(PG8_SB(1, 0), b3, voffB); PG8_STAGE(PG8_SB(1, 1), b3 + hstepB, voffB); PG8_STAGE(PG8_SA(1, 0), a3, voffA);
            PG8_WAIT_V(8); PG8_WAIT_L(0); PG8_BAR; PG8_MMA(1, 0, At, B0); PG8_MMA(1, 1, At, B1); PG8_BAR; PG8_SCHED;
            } else {
            PG8_LDB(B0, 0, 0); PG8_SCHED; PG8_LDA(At, 0, 0); PG8_STAGE(PG8_SA(1, 1), a1 + hstepA, voffA);
            PG8_WAIT_L(8); PG8_BAR; PG8_WAIT_L(0); PG8_MMA(0, 0, At, B0); PG8_BAR; PG8_SCHED;
            PG8_LDB(B1, 0, 1); PG8_STAGE(PG8_SB(0, 0), b2, voffB);
            PG8_BAR; PG8_WAIT_L(0); PG8_MMA(0, 1, At, B1); PG8_BAR;
            PG8_LDA(At, 0, 1); PG8_STAGE(PG8_SA(0, 0), a2, voffA);
            PG8_BAR; PG8_WAIT_L(0); PG8_MMA(1, 0, At, B0); PG8_BAR; PG8_SCHED;
            PG8_STAGE(PG8_SB(0, 1), b2 + hstepB, voffB);
            PG8_WAIT_V(6); PG8_BAR; PG8_MMA(1, 1, At, B1); PG8_BAR;
            PG8_LDB(B0, 1, 0); PG8_SCHED; PG8_LDA(At, 1, 0); PG8_STAGE(PG8_SA(0, 1), a2 + hstepA, voffA);
            PG8_WAIT_L(8); PG8_BAR; PG8_WAIT_L(0); PG8_MMA(0, 0, At, B0); PG8_BAR; PG8_SCHED;
            PG8_LDB(B1, 1, 1); PG8_STAGE(PG8_SB(1, 0), b3, voffB);
            PG8_BAR; PG8_WAIT_L(0); PG8_MMA(0, 1, At, B1); PG8_BAR;
            PG8_LDA(At, 1, 1); PG8_STAGE(PG8_SA(1, 0), a3, voffA);
            PG8_BAR; PG8_WAIT_L(0); PG8_MMA(1, 0, At, B0); PG8_BAR; PG8_SCHED;
            PG8_STAGE(PG8_SB(1, 1), b3 + hstepB, voffB);
            PG8_WAIT_V(6); PG8_BAR; PG8_MMA(1, 1, At, B1); PG8_BAR;
            }
        }
        if constexpr (ALIGN_EPI) { if (wr == 0) PG8_BAR; }
        if constexpr (!Epi::AFTER_DRAIN) { E(acc, cur, wr, wc, fr, fq); S.done(cur); }
        if (!has_next) break;
#pragma unroll
        for (int a = 0; a < 2; ++a)
#pragma unroll
            for (int b = 0; b < 2; ++b)
#pragma unroll
                for (int m = 0; m < 4; ++m)
#pragma unroll
                    for (int n = 0; n < 2; ++n) acc[a][b][m][n] = (f32x4){0.f, 0.f, 0.f, 0.f};
        cur = nxt; cA = nA; cB = nB; ++ui;
        if constexpr (ALIGN_EPI) { if (wr == 1) PG8_BAR; }
    }
    PG8_WAIT_V(0);
    if constexpr (!ALIGN_EPI) { if (wr == 0) PG8_BAR; }
    PG8_BAR;
    if constexpr (Epi::AFTER_DRAIN) { E.fused(acc, cur, wr, wc, fr, fq, lds, wid, lane); S.done(cur); }
#undef PG8_SA
#undef PG8_SB
#undef PG8_STAGE
#undef PG8_LDA
#undef PG8_LDB
#undef PG8_MMA
#undef PG8_WAIT_V
#undef PG8_WAIT_L
#undef PG8_BAR
#undef PG8_SCHED
}
}
#define GAS __attribute__((address_space(1)))
#define LAS __attribute__((address_space(3)))
typedef unsigned short bf16;
typedef unsigned v4u __attribute__((ext_vector_type(4)));
typedef float f32x4 __attribute__((ext_vector_type(4)));
typedef short bf16x8 __attribute__((ext_vector_type(8)));
typedef GAS unsigned gu32;
typedef GAS unsigned long long gu64;
#define RLX_AGENT __ATOMIC_RELAXED, __HIP_MEMORY_SCOPE_AGENT
#define LDS_WAIT() asm volatile("s_waitcnt lgkmcnt(0)" ::: "memory")
#define VM_WAIT() asm volatile("s_waitcnt vmcnt(0)" ::: "memory")
__device__ __forceinline__ unsigned long long rt() { return __builtin_amdgcn_s_memrealtime(); }
__device__ __forceinline__ unsigned f2bf(float f) { unsigned u = __builtin_bit_cast(unsigned, f); return (u + 0x7fffu + ((u >> 16) & 1u)) >> 16; }
__device__ __forceinline__ unsigned pk2(float lo, float hi) { return f2bf(lo) | (f2bf(hi) << 16); }

#define XB_TMO      128
#define XB_XCNT(j)  (256  + 64 * (j))
#define XB_XSUB(j)  (1280 + 64 * (j))
#define XB_XGEN(j)  (2304 + 64 * (j))
#define XB_TOP      3328
#define XB_TOPGEN   3392
#define XCD_BAR_WORDS 3456
#define XB_SPIN_CAP (1u << 18)

__device__ __forceinline__ unsigned xb_ld(unsigned* p)              { return __hip_atomic_load(p, __ATOMIC_RELAXED, __HIP_MEMORY_SCOPE_AGENT); }
__device__ __forceinline__ unsigned xb_add(unsigned* p, unsigned v) { return __hip_atomic_fetch_add(p, v, __ATOMIC_RELAXED, __HIP_MEMORY_SCOPE_AGENT); }
__device__ __forceinline__ unsigned xb_xcc_id() { return (unsigned)__builtin_amdgcn_s_getreg((3 << 11) | 20) & 0xFu; }
#define XB_SPIN(cond, bar) do { unsigned _sp = 0; while (cond) { __builtin_amdgcn_s_sleep(1); \
    if ((++_sp & 255u) == 0u) { if (xb_ld(&(bar)[XB_TMO])) break; if (_sp > XB_SPIN_CAP) { atomicAdd(&(bar)[XB_TMO], 1u); break; } } } } while (0)

struct XcdBarrier {
    unsigned* bar; unsigned x;
    volatile LAS unsigned* st;
};

__device__ __forceinline__ XcdBarrier xcd_barrier_post(unsigned* bar, volatile LAS unsigned* st) {
    XcdBarrier b; b.bar = bar; b.x = xb_xcc_id(); b.st = st;
    if (threadIdx.x == 0) (void)xb_add(&bar[XB_XCNT(b.x)], 1u);
    return b;
}
__device__ __forceinline__ void xcd_barrier_complete(unsigned* bar, unsigned x, unsigned& nloc, unsigned& nx) {
    const unsigned G = gridDim.x * gridDim.y * gridDim.z;
    unsigned sum, cnt, mine, sp = 0u;
    for (;;) {
        sum = 0u; cnt = 0u; mine = 0u;
#pragma unroll
        for (unsigned j = 0; j < 16; ++j) { const unsigned c = xb_ld(&bar[XB_XCNT(j)]); sum += c; cnt += (c > 0u) ? 1u : 0u; mine = (j == x) ? c : mine; }
        if (sum == G) break;
        __builtin_amdgcn_s_sleep(1);
        if ((++sp & 255u) == 0u) { if (xb_ld(&bar[XB_TMO])) break; if (sp > XB_SPIN_CAP) { atomicAdd(&bar[XB_TMO], 1u); break; } }
    }
    nloc = mine > 0u ? mine : 1u; nx = cnt > 0u ? cnt : 1u;
}

__device__ __forceinline__ void xcd_barrier(const XcdBarrier& b) {
    asm volatile("s_waitcnt vmcnt(0)" ::: "memory");
    __syncthreads();
    if (threadIdx.x == 0) {
        unsigned* bar = b.bar;
        __builtin_amdgcn_s_waitcnt(0);
        unsigned nloc = b.st[0], nx = b.st[1];
        if (nloc == 0u) { xcd_barrier_complete(bar, b.x, nloc, nx); b.st[0] = nloc; b.st[1] = nx; }
        const unsigned old = xb_add(&bar[XB_XSUB(b.x)], 1u);
        const unsigned gen = old / nloc;
        if (old + 1u == (gen + 1u) * nloc) {
            __builtin_amdgcn_fence(__ATOMIC_RELEASE, "agent");
            asm volatile("s_waitcnt vmcnt(0)" ::: "memory");
            const unsigned og = xb_add(&bar[XB_TOP], 1u);
            const unsigned tg = og / nx;
            if (og + 1u == (tg + 1u) * nx) xb_add(&bar[XB_TOPGEN], 1u);
            else XB_SPIN(xb_ld(&bar[XB_TOPGEN]) == tg, bar);
            __builtin_amdgcn_fence(__ATOMIC_ACQUIRE, "agent");
            xb_add(&bar[XB_XGEN(b.x)], 1u);
            asm volatile("s_waitcnt vmcnt(0)" ::: "memory");
        } else {
            XB_SPIN(xb_ld(&bar[XB_XGEN(b.x)]) == gen, bar);
            __builtin_amdgcn_fence(__ATOMIC_ACQUIRE, "agent");
            asm volatile("s_waitcnt vmcnt(0)" ::: "memory");
        }
    }
    __syncthreads();
}

constexpr int NWAVES = 8, NTHREADS = 512;
constexpr int DM = 1024, NBATCH = 8, SEQ = 2048, MTOK = NBATCH * SEQ, NMEM = 256, MMEM = NBATCH * NMEM, DFF = 2816, INC = 3592;
constexpr int PW = 3584;
constexpr float EPS = 1e-6f;
constexpr size_t MiB = 1u << 20;
constexpr size_t WS_CTL = 0, CTL_ZERO_BYTES = 1 * MiB;
constexpr size_t WS_W1GU = 1 * MiB, WS_W1D = 12 * MiB, WS_WIN = 35 * MiB / 2, WS_WKV = 25 * MiB, WS_WOUT = 29 * MiB, WS_WQ = 31 * MiB, WS_WO = 33 * MiB, WS_W2GU = 35 * MiB, WS_W2D = 46 * MiB;
constexpr size_t WS_XN = 52 * MiB;
constexpr size_t WS_QN = 52 * MiB, WS_KN = 68 * MiB;
constexpr size_t WS_BIG = 88 * MiB;
constexpr size_t WS_HB = 88 * MiB;
constexpr size_t WS_PROJ = 88 * MiB;
constexpr size_t WS_Q = 88 * MiB;
constexpr size_t WS_T1 = 200 * MiB;
constexpr size_t WS_VV = 200 * MiB;
constexpr size_t WS_AB = 232 * MiB, WS_BETA = 233 * MiB, WS_GG = 234 * MiB;
constexpr size_t WS_KM = 240 * MiB, WS_VM = 244 * MiB, WS_END = 248 * MiB;
static_assert(WS_WIN + (size_t)3840 * 1024 * 2 == WS_WKV, "Wkv rows must directly follow Win rows");
constexpr int CW_BAR = 4096;
constexpr int RING_OFF = 0, RING_BYTES = 131072, LDSCTL_OFF = RING_BYTES, MISC_OFF = LDSCTL_OFF + 320, LDS_BYTES = 147456;

struct Frame {
    LAS unsigned char* lds; volatile LAS unsigned* MISC; gu32* ctl;
    int tid, lane, wave, vcu, G;
};
__device__ __forceinline__ float wave_sum(float v) {
#pragma unroll
    for (int o = 1; o < 64; o <<= 1) v += __shfl_xor(v, o);
    return v;
}
__device__ __forceinline__ float wave_max(float v) {
#pragma unroll
    for (int o = 1; o < 64; o <<= 1) v = fmaxf(v, __shfl_xor(v, o));
    return v;
}
__device__ __forceinline__ float bf2f(unsigned short b) { return __uint_as_float((unsigned)b << 16); }
__device__ __forceinline__ float bflo(unsigned w) { return __uint_as_float(w << 16); }
__device__ __forceinline__ float bfhi(unsigned w) { return __uint_as_float(w & 0xffff0000u); }
__device__ __forceinline__ float silu_f(float x) { return x / (1.f + __expf(-x)); }

__device__ __forceinline__ void transpose_item(const float* W, int ldw, int K, int k0, int srcbase, int nvalid, bf16* WT, int dstrow0, LAS float* scr, int lane) {
    const int nl = lane & 31; const bool ok = nl < nvalid;
#pragma unroll 8
    for (int i = 0; i < 32; ++i) { const int kk = 2 * i + (lane >> 5); scr[kk * 33 + nl] = ok ? W[(size_t)(k0 + kk) * ldw + srcbase + nl] : 0.f; }
    LDS_WAIT(); asm volatile("" ::: "memory");
    const int c = lane & 7;
#pragma unroll
    for (int j = 0; j < 4; ++j) { const int n = (lane >> 3) + 8 * j; const LAS float* s = scr + (8 * c) * 33 + n;
        v4u o; o.x = pk2(s[0 * 33], s[1 * 33]); o.y = pk2(s[2 * 33], s[3 * 33]); o.z = pk2(s[4 * 33], s[5 * 33]); o.w = pk2(s[6 * 33], s[7 * 33]);
        *(GAS v4u*)(WT + (size_t)(dstrow0 + n) * K + k0 + 8 * c) = o; }
    LDS_WAIT(); asm volatile("" ::: "memory");
}
__device__ __forceinline__ void conv_gu(const float* wg, const float* wu, bf16* WT, LAS float* scr, int it, int lane) {
    const int which = it / 1408, r = it % 1408, kb = r / 88, nb = r % 88, n0 = nb * 32;
    transpose_item(which ? wu : wg, DFF, DM, kb * 64, n0, 32, WT, 256 * (n0 >> 7) + (which ? 128 : 0) + (n0 & 127), scr, lane);
}
__device__ __forceinline__ void conv_plain(const float* w, int K, int N, bf16* WT, int rowoff, LAS float* scr, int it, int lane) {
    const int nblk = N / 32, kb = it / nblk, nb = it % nblk;
    transpose_item(w, N, K, kb * 64, nb * 32, 32, WT, rowoff + nb * 32, scr, lane);
}
__device__ __forceinline__ void conv_win(const float* w, bf16* WT, LAS float* scr, int it, int lane) {
    const int kb = it / 120, db = it % 120, d0 = db * 32;
    int srcbase = d0, nvalid = 32;
    if (d0 >= 2048 && d0 < 3584) srcbase = d0 + 8; else if (d0 == 3584) { srcbase = 2048; nvalid = 8; } else if (d0 > 3584) { srcbase = 0; nvalid = 0; }
    transpose_item(w, INC, DM, kb * 64, srcbase, nvalid, WT, d0, scr, lane);
}
__device__ __forceinline__ void norm_row_bf16(const float* xrow, const float* g, bf16* orow, int lane) {
    const GAS f32x4* xr = (const GAS f32x4*)xrow + lane; const GAS f32x4* gr = (const GAS f32x4*)g + lane;
    f32x4 v[4]; float s = 0.f;
#pragma unroll
    for (int j = 0; j < 4; ++j) { v[j] = xr[64 * j]; s += (v[j].x * v[j].x + v[j].y * v[j].y) + (v[j].z * v[j].z + v[j].w * v[j].w); }
    const float r = rsqrtf(wave_sum(s) * (1.f / DM) + EPS);
    GAS unsigned long long* o8 = (GAS unsigned long long*)orow + lane;
#pragma unroll
    for (int j = 0; j < 4; ++j) { const f32x4 gg = gr[64 * j]; o8[64 * j] = (unsigned long long)pk2(v[j].x * r * gg.x, v[j].y * r * gg.y) | ((unsigned long long)pk2(v[j].z * r * gg.z, v[j].w * r * gg.w) << 32); }
}
struct In { const float* p[27]; };
__device__ __forceinline__ void p0_prologue(Frame& F, const In& in, unsigned char* ws) {
    LAS float* scr = (LAS float*)(F.lds + RING_OFF + F.wave * 16384);
    const int gw = F.vcu * NWAVES + F.wave, NGW = F.G * NWAVES;
    constexpr int I_GU = 2 * 16 * 88, I_D = 44 * 32, I_IN = 16 * 120, I_SQ = 16 * 32;
    constexpr int NITEMS = 2 * I_GU + 2 * I_D + I_IN + 5 * I_SQ;
    for (int it = gw; it < NITEMS; it += NGW) {
        int r = it;
        if (r < I_GU) { conv_gu(in.p[3], in.p[4], (bf16*)(ws + WS_W1GU), scr, r, F.lane); continue; } r -= I_GU;
        if (r < I_D) { conv_plain(in.p[5], DFF, DM, (bf16*)(ws + WS_W1D), 0, scr, r, F.lane); continue; } r -= I_D;
        if (r < I_IN) { conv_win(in.p[8], (bf16*)(ws + WS_WIN), scr, r, F.lane); continue; } r -= I_IN;
        if (r < I_SQ) { conv_plain(in.p[18], DM, DM, (bf16*)(ws + WS_WKV), 0, scr, r, F.lane); continue; } r -= I_SQ;
        if (r < I_SQ) { conv_plain(in.p[19], DM, DM, (bf16*)(ws + WS_WKV), 1024, scr, r, F.lane); continue; } r -= I_SQ;
        if (r < I_SQ) { conv_plain(in.p[13], DM, DM, (bf16*)(ws + WS_WOUT), 0, scr, r, F.lane); continue; } r -= I_SQ;
        if (r < I_SQ) { conv_plain(in.p[17], DM, DM, (bf16*)(ws + WS_WQ), 0, scr, r, F.lane); continue; } r -= I_SQ;
        if (r < I_SQ) { conv_plain(in.p[20], DM, DM, (bf16*)(ws + WS_WO), 0, scr, r, F.lane); continue; } r -= I_SQ;
        if (r < I_GU) { conv_gu(in.p[23], in.p[24], (bf16*)(ws + WS_W2GU), scr, r, F.lane); continue; } r -= I_GU;
        conv_plain(in.p[25], DFF, DM, (bf16*)(ws + WS_W2D), 0, scr, r, F.lane);
    }
    bf16* XN = (bf16*)(ws + WS_XN);
    for (int m = gw; m < MTOK + MMEM; m += NGW) {
        if (m < MTOK) norm_row_bf16(in.p[0] + (size_t)m * DM, in.p[2], XN + (size_t)m * DM, F.lane);
        else norm_row_bf16(in.p[1] + (size_t)(m - MTOK) * DM, in.p[16], XN + (size_t)m * DM, F.lane);
    }
}
__device__ __forceinline__ void norm_pass(Frame& F, const float* xin, const bf16* f, const float* g1, float scale, float* xout, const float* g2, bf16* XN) {
    const int gw = F.vcu * NWAVES + F.wave, NGW = F.G * NWAVES;
    for (int m = gw; m < MTOK; m += NGW) {
        const GAS f32x4* xr = (const GAS f32x4*)(xin + (size_t)m * DM) + F.lane;
        const GAS unsigned long long* fr = (const GAS unsigned long long*)(f + (size_t)m * DM) + F.lane;
        const GAS f32x4* g1r = (const GAS f32x4*)g1 + F.lane;
        f32x4 fv[4]; float s = 0.f;
#pragma unroll
        for (int j = 0; j < 4; ++j) { const unsigned long long w = fr[64 * j]; const unsigned lo = (unsigned)w, hi = (unsigned)(w >> 32);
            fv[j] = (f32x4){bflo(lo), bfhi(lo), bflo(hi), bfhi(hi)}; s += (fv[j].x * fv[j].x + fv[j].y * fv[j].y) + (fv[j].z * fv[j].z + fv[j].w * fv[j].w); }
        const float r1 = rsqrtf(wave_sum(s) * (1.f / DM) + EPS) * scale;
        float s2 = 0.f;
        GAS f32x4* xo = (GAS f32x4*)(xout + (size_t)m * DM) + F.lane;
#pragma unroll
        for (int j = 0; j < 4; ++j) { const f32x4 xx = xr[64 * j]; const f32x4 gg = g1r[64 * j];
            fv[j] = xx + fv[j] * gg * r1; s2 += (fv[j].x * fv[j].x + fv[j].y * fv[j].y) + (fv[j].z * fv[j].z + fv[j].w * fv[j].w); xo[64 * j] = fv[j]; }
        if (g2) {
            const float r2 = rsqrtf(wave_sum(s2) * (1.f / DM) + EPS);
            const GAS f32x4* g2r = (const GAS f32x4*)g2 + F.lane;
            GAS unsigned long long* o8 = (GAS unsigned long long*)(XN + (size_t)m * DM) + F.lane;
#pragma unroll
            for (int j = 0; j < 4; ++j) { const f32x4 gg = g2r[64 * j]; o8[64 * j] = (unsigned long long)pk2(fv[j].x * r2 * gg.x, fv[j].y * r2 * gg.y) | ((unsigned long long)pk2(fv[j].z * r2 * gg.z, fv[j].w * r2 * gg.w) << 32); }
        }
    }
}
__device__ __forceinline__ void gdn_prep(Frame& F, const bf16* P, const float* AB, const float* convw, const float* a_log, const float* dt_bias, bf16* QN, bf16* KN, float* VV, float* BETA, float* GG) {
    const int gw = F.vcu * NWAVES + F.wave, NGW = F.G * NWAVES, lane = F.lane;
    for (int it = gw; it < MTOK * 4; it += NGW) {
        const int row = it >> 2, h = it & 3, t = row & (SEQ - 1);
        const int c = h * 128 + 2 * lane;
        float yq[2] = {0.f, 0.f}, yk[2] = {0.f, 0.f}, yv[2] = {0.f, 0.f};
#pragma unroll
        for (int j = 0; j < 4; ++j) {
            if (t - 3 + j >= 0) {
                const bf16* r = P + (size_t)(row - 3 + j) * PW;
                const unsigned wq = *(const unsigned*)(r + c), wk = *(const unsigned*)(r + 512 + c), wv = *(const unsigned*)(r + 1024 + c);
                const float2 cq = *(const float2*)(convw + j * 1536 + c), ck = *(const float2*)(convw + j * 1536 + 512 + c), cv = *(const float2*)(convw + j * 1536 + 1024 + c);
                yq[0] += cq.x * bflo(wq); yq[1] += cq.y * bfhi(wq); yk[0] += ck.x * bflo(wk); yk[1] += ck.y * bfhi(wk); yv[0] += cv.x * bflo(wv); yv[1] += cv.y * bfhi(wv);
            }
        }
#pragma unroll
        for (int e = 0; e < 2; ++e) { yq[e] = silu_f(yq[e]); yk[e] = silu_f(yk[e]); yv[e] = silu_f(yv[e]); }
        const float rq = rsqrtf(wave_sum(yq[0] * yq[0] + yq[1] * yq[1]) + EPS) * 0.08838834764831845f;
        const float rk = rsqrtf(wave_sum(yk[0] * yk[0] + yk[1] * yk[1]) + EPS);
        *(unsigned*)(QN + (size_t)row * 512 + c) = pk2(yq[0] * rq, yq[1] * rq);
        *(unsigned*)(KN + (size_t)row * 512 + c) = pk2(yk[0] * rk, yk[1] * rk);
        *(float2*)(VV + (size_t)row * 512 + c) = make_float2(yv[0], yv[1]);
        if (lane == 0) {
            const float a = AB[(size_t)row * 8 + h], bb = AB[(size_t)row * 8 + 4 + h];
            BETA[(size_t)row * 4 + h] = 1.f / (1.f + expf(-bb));
            const float xx = a + dt_bias[h];
            GG[(size_t)row * 4 + h] = -expf(a_log[h]) * ((xx > 20.f) ? xx : log1pf(expf(xx)));
        }
    }
}
__device__ __forceinline__ void gdn_rec(Frame& F, const bf16* QN, const bf16* KN, float* VV, const float* BETA, const float* GG) {
    LAS float* ks = (LAS float*)(F.lds); LAS float* qs = ks + 128; LAS float* red = qs + 128;
    const int tid = F.tid, col = tid & 15, grp = tid >> 4;
    for (int item = F.vcu; item < NBATCH * 4 * 8; item += F.G) {
        const int bh = item >> 3, sl = item & 7, b = bh >> 2, h = bh & 3;
        float S[4] = {0.f, 0.f, 0.f, 0.f};
        for (int t = 0; t < SEQ; ++t) {
            const size_t row = (size_t)b * SEQ + t;
            if (tid < 128) ks[tid] = bf2f(KN[row * 512 + h * 128 + tid]); else if (tid < 256) qs[tid - 128] = bf2f(QN[row * 512 + h * 128 + tid - 128]);
            const float vt = VV[row * 512 + h * 128 + sl * 16 + col];
            const float bt = BETA[row * 4 + h];
            const float eg = expf(GG[row * 4 + h]);
            __syncthreads();
            float p = 0.f;
#pragma unroll
            for (int i = 0; i < 4; ++i) p = fmaf(ks[grp * 4 + i], S[i], p);
            red[grp * 16 + col] = p;
            __syncthreads();
            float kS = 0.f;
#pragma unroll
            for (int g2 = 0; g2 < 32; ++g2) kS += red[g2 * 16 + col];
            __syncthreads();
            float o = 0.f;
#pragma unroll
            for (int i = 0; i < 4; ++i) { const float kk = ks[grp * 4 + i]; S[i] = eg * (S[i] - bt * kk * kS) + bt * kk * vt; o = fmaf(S[i], qs[grp * 4 + i], o); }
            red[grp * 16 + col] = o;
            __syncthreads();
            if (grp == 0) { float os = 0.f;
#pragma unroll
                for (int g2 = 0; g2 < 32; ++g2) os += red[g2 * 16 + col];
                VV[row * 512 + h * 128 + sl * 16 + col] = os; }
            __syncthreads();
        }
    }
}
__device__ __forceinline__ void gdn_gate(Frame& F, const float* OV, const float* ng, bf16* P) {
    const int gw = F.vcu * NWAVES + F.wave, NGW = F.G * NWAVES, lane = F.lane;
    for (int it = gw; it < MTOK * 4; it += NGW) {
        const int row = it >> 2, h = it & 3, d = 2 * lane;
        const float2 o = *(const float2*)(OV + (size_t)row * 512 + h * 128 + d);
        const float r = rsqrtf(wave_sum(o.x * o.x + o.y * o.y) * (1.f / 128.f) + EPS);
        const unsigned zw = *(const unsigned*)(P + (size_t)row * PW + 1536 + h * 128 + d);
        const float2 g = *(const float2*)(ng + d);
        *(unsigned*)(P + (size_t)row * PW + h * 128 + d) = pk2(o.x * r * g.x * silu_f(bflo(zw)), o.y * r * g.y * silu_f(bfhi(zw)));
    }
}
__device__ __forceinline__ void swa_naive(Frame& F, bf16* P) {
    for (int idx = F.vcu * NTHREADS + F.tid; idx < MTOK * 8; idx += F.G * NTHREADS) {
        const int t = idx & (SEQ - 1), h = (idx >> 11) & 7, b = idx >> 14;
        const float slope = exp2f(-(float)(h + 1));
        const bf16* base = P + (size_t)b * SEQ * PW;
        float q[64], o[64];
        { const v4u* qp = (const v4u*)(base + (size_t)t * PW + 2048 + h * 64);
#pragma unroll
          for (int i = 0; i < 8; ++i) { const v4u w = qp[i]; q[8 * i] = bflo(w.x); q[8 * i + 1] = bfhi(w.x); q[8 * i + 2] = bflo(w.y); q[8 * i + 3] = bfhi(w.y); q[8 * i + 4] = bflo(w.z); q[8 * i + 5] = bfhi(w.z); q[8 * i + 6] = bflo(w.w); q[8 * i + 7] = bfhi(w.w); } }
#pragma unroll
        for (int i = 0; i < 64; ++i) o[i] = 0.f;
        float m = -INFINITY, l = 0.f;
        for (int br = 0; br < 3; ++br) {
            const int dil = (br == 0) ? 1 : (br == 1 ? 4 : 16);
            for (int dl = 0; dl <= 128; ++dl) {
                const int tk = t - dl * dil;
                if (tk < 0) break;
                const v4u* kp = (const v4u*)(base + (size_t)tk * PW + 2560 + h * 64);
                float s = 0.f;
#pragma unroll
                for (int i = 0; i < 8; ++i) { const v4u w = kp[i];
                    s = fmaf(q[8 * i], bflo(w.x), s); s = fmaf(q[8 * i + 1], bfhi(w.x), s); s = fmaf(q[8 * i + 2], bflo(w.y), s); s = fmaf(q[8 * i + 3], bfhi(w.y), s);
                    s = fmaf(q[8 * i + 4], bflo(w.z), s); s = fmaf(q[8 * i + 5], bfhi(w.z), s); s = fmaf(q[8 * i + 6], bflo(w.w), s); s = fmaf(q[8 * i + 7], bfhi(w.w), s); }
                s = s * 0.125f - slope * (float)(dil * dl);
                const float mn = fmaxf(m, s);
                const float c = __expf(m - mn), p = __expf(s - mn);
                l = l * c + p; m = mn;
                const v4u* vp = (const v4u*)(base + (size_t)tk * PW + 3072 + h * 64);
#pragma unroll
                for (int i = 0; i < 8; ++i) { const v4u w = vp[i];
                    o[8 * i] = o[8 * i] * c + p * bflo(w.x); o[8 * i + 1] = o[8 * i + 1] * c + p * bfhi(w.x); o[8 * i + 2] = o[8 * i + 2] * c + p * bflo(w.y); o[8 * i + 3] = o[8 * i + 3] * c + p * bfhi(w.y);
                    o[8 * i + 4] = o[8 * i + 4] * c + p * bflo(w.z); o[8 * i + 5] = o[8 * i + 5] * c + p * bfhi(w.z); o[8 * i + 6] = o[8 * i + 6] * c + p * bflo(w.w); o[8 * i + 7] = o[8 * i + 7] * c + p * bfhi(w.w); }
            }
        }
        const float il = 1.f / l;
        v4u* op = (v4u*)(P + ((size_t)b * SEQ + t) * PW + 512 + h * 64);
#pragma unroll
        for (int i = 0; i < 8; ++i) { v4u w; w.x = pk2(o[8 * i] * il, o[8 * i + 1] * il); w.y = pk2(o[8 * i + 2] * il, o[8 * i + 3] * il); w.z = pk2(o[8 * i + 4] * il, o[8 * i + 5] * il); w.w = pk2(o[8 * i + 6] * il, o[8 * i + 7] * il); op[i] = w; }
    }
}
__device__ __forceinline__ void xattn_naive(Frame& F, const bf16* Q, const bf16* KM, const bf16* VM, bf16* O) {
    LAS float* qs = (LAS float*)F.lds;
    LAS float* ps = qs + 2048;
    const int tid = F.tid, w = F.wave, lane = F.lane, rr = w >> 2, hd = w & 3;
    for (int rp = F.vcu; rp < MTOK / 2; rp += F.G) {
        const size_t row0 = (size_t)rp * 2;
        { const unsigned long long wq = *(const unsigned long long*)(Q + row0 * DM + tid * 4); const unsigned lo = (unsigned)wq, hi = (unsigned)(wq >> 32);
          qs[tid * 4] = bflo(lo); qs[tid * 4 + 1] = bfhi(lo); qs[tid * 4 + 2] = bflo(hi); qs[tid * 4 + 3] = bfhi(hi); }
        __syncthreads();
        const size_t row = row0 + rr; const int b = (int)(row >> 11);
        float sc[4];
#pragma unroll
        for (int i = 0; i < 4; ++i) {
            const int mk = lane + 64 * i;
            const v4u* kp = (const v4u*)(KM + ((size_t)b * NMEM + mk) * DM + hd * 256);
            const LAS float* qq = qs + rr * 1024 + hd * 256;
            float s = 0.f;
            for (int d8 = 0; d8 < 32; ++d8) { const v4u kw = kp[d8];
                s = fmaf(qq[8 * d8], bflo(kw.x), s); s = fmaf(qq[8 * d8 + 1], bfhi(kw.x), s); s = fmaf(qq[8 * d8 + 2], bflo(kw.y), s); s = fmaf(qq[8 * d8 + 3], bfhi(kw.y), s);
                s = fmaf(qq[8 * d8 + 4], bflo(kw.z), s); s = fmaf(qq[8 * d8 + 5], bfhi(kw.z), s); s = fmaf(qq[8 * d8 + 6], bflo(kw.w), s); s = fmaf(qq[8 * d8 + 7], bfhi(kw.w), s); }
            sc[i] = s * 0.0625f;
        }
        const float mx = wave_max(fmaxf(fmaxf(sc[0], sc[1]), fmaxf(sc[2], sc[3])));
        float e[4]; float sum = 0.f;
#pragma unroll
        for (int i = 0; i < 4; ++i) { e[i] = __expf(sc[i] - mx); sum += e[i]; }
        const float inv = 1.f / wave_sum(sum);
#pragma unroll
        for (int i = 0; i < 4; ++i) ps[w * 256 + lane + 64 * i] = e[i] * inv;
        __syncthreads();
        float a0 = 0.f, a1 = 0.f, a2 = 0.f, a3 = 0.f;
        for (int mk = 0; mk < NMEM; ++mk) {
            const float p = ps[w * 256 + mk];
            const unsigned long long vw = *(const unsigned long long*)(VM + ((size_t)b * NMEM + mk) * DM + hd * 256 + lane * 4); const unsigned lo = (unsigned)vw, hi = (unsigned)(vw >> 32);
            a0 = fmaf(p, bflo(lo), a0); a1 = fmaf(p, bfhi(lo), a1); a2 = fmaf(p, bflo(hi), a2); a3 = fmaf(p, bfhi(hi), a3);
        }
        *(unsigned long long*)(O + row * DM + hd * 256 + lane * 4) = (unsigned long long)pk2(a0, a1) | ((unsigned long long)pk2(a2, a3) << 32);
        __syncthreads();
    }
}

struct Args { const float* in[27]; float* out; unsigned char* ws; };
__global__ void __launch_bounds__(NTHREADS, 2) mk_fwd(Args args) {
    extern __shared__ __attribute__((aligned(16))) unsigned char lds[];
    Frame F;
    F.lds = (LAS unsigned char*)lds;
    F.MISC = (volatile LAS unsigned*)(F.lds + MISC_OFF);
    F.tid = threadIdx.x; F.lane = F.tid & 63; F.wave = __builtin_amdgcn_readfirstlane(F.tid >> 6);
    F.G = gridDim.x; { const int bx = blockIdx.x; F.vcu = (F.G % 8 == 0) ? (bx % 8) * (F.G / 8) + bx / 8 : bx; }
    unsigned char* ws = args.ws;
    F.ctl = (gu32*)(ws + WS_CTL);
    for (int u = F.tid; u < (LDS_BYTES - LDSCTL_OFF) / 4; u += NTHREADS) ((LAS unsigned*)(F.lds + LDSCTL_OFF))[u] = 0u;
    __syncthreads();
    XcdBarrier bar = xcd_barrier_post((unsigned*)(F.ctl + CW_BAR), F.MISC + 8);
#define GRID_BAR() xcd_barrier(bar)
    In in;
#pragma unroll
    for (int i = 0; i < 27; ++i) in.p[i] = args.in[i];
    float* out = args.out;
    bf16* XN = (bf16*)(ws + WS_XN); bf16* HB = (bf16*)(ws + WS_HB); bf16* PROJ = (bf16*)(ws + WS_PROJ); bf16* T1 = (bf16*)(ws + WS_T1); bf16* QB = (bf16*)(ws + WS_Q);
    bf16* KM = (bf16*)(ws + WS_KM); bf16* VM = (bf16*)(ws + WS_VM); float* AB = (float*)(ws + WS_AB);
    bf16* QN = (bf16*)(ws + WS_QN); bf16* KN = (bf16*)(ws + WS_KN); float* VV = (float*)(ws + WS_VV); float* BETA = (float*)(ws + WS_BETA); float* GG = (float*)(ws + WS_GG);
    const int bid = (int)blockIdx.x;

    p0_prologue(F, in, ws); GRID_BAR();
    { pg8::Gemm g{XN, (const bf16*)(ws + WS_W1GU), MTOK, 2 * DFF, DM, DM}; pg8::StaticOrder S; S.init(MTOK, 2 * DFF, F.G, bid); pg8::EpiSwiglu E{HB, DFF};
      pg8::gemm_phase<pg8::EpiSwiglu, pg8::StaticOrder, true, true>(F.lds + RING_OFF, g, S, E); GRID_BAR(); }
    { pg8::Gemm g{HB, (const bf16*)(ws + WS_W1D), MTOK, DM, DFF, DFF}; pg8::StaticOrder S; S.init(MTOK, DM, F.G, bid); pg8::EpiBf16 E{T1, DM};
      pg8::gemm_phase<pg8::EpiBf16, pg8::StaticOrder, true, true>(F.lds + RING_OFF, g, S, E); GRID_BAR(); }
    norm_pass(F, in.p[0], T1, in.p[6], 0.5f, out, in.p[7], XN); GRID_BAR();
    { pg8::Gemm g{XN, (const bf16*)(ws + WS_WIN), MTOK + MMEM, 3840 + 2048, DM, DM}; pg8::ProjKvOrder S; S.init(F.G, bid); pg8::EpiProjKv E{PROJ, AB, KM, VM};
      pg8::gemm_phase<pg8::EpiProjKv, pg8::ProjKvOrder, true, true>(F.lds + RING_OFF, g, S, E); GRID_BAR(); }
    gdn_prep(F, PROJ, AB, in.p[9], in.p[10], in.p[11], QN, KN, VV, BETA, GG); GRID_BAR();
    gdn_rec(F, QN, KN, VV, BETA, GG); GRID_BAR();
    gdn_gate(F, VV, in.p[12], PROJ); swa_naive(F, PROJ); GRID_BAR();
    { pg8::Gemm g{PROJ, (const bf16*)(ws + WS_WOUT), MTOK, DM, DM, PW}; pg8::StaticOrder S; S.init(MTOK, DM, F.G, bid); pg8::EpiBf16 E{T1, DM};
      pg8::gemm_phase<pg8::EpiBf16, pg8::StaticOrder, true, true>(F.lds + RING_OFF, g, S, E); GRID_BAR(); }
    norm_pass(F, out, T1, in.p[14], 1.0f, out, in.p[15], XN); GRID_BAR();
    { pg8::Gemm g{XN, (const bf16*)(ws + WS_WQ), MTOK, DM, DM, DM}; pg8::StaticOrder S; S.init(MTOK, DM, F.G, bid); pg8::EpiBf16 E{QB, DM};
      pg8::gemm_phase<pg8::EpiBf16, pg8::StaticOrder, true, true>(F.lds + RING_OFF, g, S, E); GRID_BAR(); }
    xattn_naive(F, QB, KM, VM, XN); GRID_BAR();
    { pg8::Gemm g{XN, (const bf16*)(ws + WS_WO), MTOK, DM, DM, DM}; pg8::StaticOrder S; S.init(MTOK, DM, F.G, bid); pg8::EpiBf16 E{T1, DM};
      pg8::gemm_phase<pg8::EpiBf16, pg8::StaticOrder, true, true>(F.lds + RING_OFF, g, S, E); GRID_BAR(); }
    norm_pass(F, out, T1, in.p[21], 1.0f, out, in.p[22], XN); GRID_BAR();
    { pg8::Gemm g{XN, (const bf16*)(ws + WS_W2GU), MTOK, 2 * DFF, DM, DM}; pg8::StaticOrder S; S.init(MTOK, 2 * DFF, F.G, bid); pg8::EpiSwiglu E{HB, DFF};
      pg8::gemm_phase<pg8::EpiSwiglu, pg8::StaticOrder, true, true>(F.lds + RING_OFF, g, S, E); GRID_BAR(); }
    { pg8::Gemm g{HB, (const bf16*)(ws + WS_W2D), MTOK, DM, DFF, DFF}; pg8::StaticOrder S; S.init(MTOK, DM, F.G, bid); pg8::EpiBf16 E{T1, DM};
      pg8::gemm_phase<pg8::EpiBf16, pg8::StaticOrder, true, true>(F.lds + RING_OFF, g, S, E); GRID_BAR(); }
    norm_pass(F, out, T1, in.p[26], 0.5f, out, nullptr, nullptr);
#undef GRID_BAR
}

extern "C" void kernel_launch(void* const* d_in, const int* in_sizes, int n_in, void* d_out, int out_size, void* d_ws, size_t ws_size, hipStream_t stream) {
    static int grid = 0;
    if (grid == 0) {
        if (n_in != 27 || out_size != MTOK * DM || ws_size < WS_END) { fprintf(stderr, "kernel_launch: unexpected shapes (n_in %d, out %d, ws %zu)\n", n_in, out_size, ws_size); grid = -1; return; }
        int dev = 0, cus = 0, per_cu = 0;
        if (hipGetDevice(&dev) != hipSuccess || hipDeviceGetAttribute(&cus, hipDeviceAttributeMultiprocessorCount, dev) != hipSuccess) { grid = -1; return; }
        if (hipFuncSetAttribute((const void*)mk_fwd, hipFuncAttributeMaxDynamicSharedMemorySize, LDS_BYTES) != hipSuccess) { fprintf(stderr, "kernel_launch: hipFuncSetAttribute failed\n"); grid = -1; return; }
        if (hipOccupancyMaxActiveBlocksPerMultiprocessor(&per_cu, (const void*)mk_fwd, NTHREADS, LDS_BYTES) != hipSuccess || per_cu < 1) fprintf(stderr, "kernel_launch: occupancy query reports %d\n", per_cu);
        (void)hipGetLastError();
        grid = cus;
    }
    if (grid < 0) return;
    if (hipMemsetAsync((char*)d_ws + WS_CTL, 0, CTL_ZERO_BYTES, stream) != hipSuccess) return;
    Args a{};
    for (int i = 0; i < 27; ++i) a.in[i] = (const float*)d_in[i];
    a.out = (float*)d_out; a.ws = (unsigned char*)d_ws;
    hipLaunchKernelGGL(mk_fwd, dim3(grid), dim3(NTHREADS), LDS_BYTES, stream, a);
}
```

```cpp
#include <hip/hip_runtime.h>
#include <cstdio>
#include <cstdint>
#include <cmath>
namespace pg8 {
#define PG8_LAS __attribute__((address_space(3)))
typedef unsigned short bf16_t;
typedef short bf16x8 __attribute__((ext_vector_type(8)));
typedef float f32x4 __attribute__((ext_vector_type(4)));
typedef unsigned u32x4 __attribute__((ext_vector_type(4)));
constexpr int BM = 256, BK = 64, HALF = 128, HTB = HALF * BK * 2  , STAGE_BYTES = 8 * HTB, NXCD = 8, WGM = 8;
__host__ __device__ __forceinline__ int lds_byte(int r, int c) { const int st = (r >> 4) * 2 + (c >> 5), rr = r & 15, cc = c & 31, ob = rr * 64 + cc * 2; return st * 1024 + (ob ^ (((ob >> 9) & 1) << 5)); }
__host__ __device__ __forceinline__ void stage_rc(int b, int& R, int& C) { const int st = b / 1024, sb = b % 1024, swz = sb ^ (((sb >> 9) & 1) << 5); R = (st >> 1) * 16 + swz / 64; C = (st & 1) * 32 + (swz % 64) / 2; }
__host__ __device__ __forceinline__ int perm32(int rho) { const int n = rho >> 4, i = rho & 15; return 8 * (i >> 2) + 4 * n + (i & 3); }
struct Unit { int pm, pn; };
struct Gemm { const bf16_t* A; const bf16_t* Bt; int M, N, K, lda; };

struct StaticOrder {
    int nM, nN, nwg, G, c;
    __host__ __device__ void init(int M, int N, int G_, int c_) { nM = M / BM; nN = N / BM; nwg = nM * nN; G = G_; c = c_; }
    __host__ __device__ bool next(int i, Unit& u) const {
        const long L = (long)i * G + c; if (L >= nwg) return false;
        int wgid = (int)L; { const int q = nwg / NXCD, r = nwg % NXCD, xcd = wgid % NXCD, off = wgid / NXCD; wgid = (xcd < r ? xcd * (q + 1) : r * (q + 1) + (xcd - r) * q) + off; }
        const int nig = WGM * nN, gid = wgid / nig, fm = gid * WGM, gsz = (nM - fm) < WGM ? (nM - fm) : WGM;
        u.pm = fm + ((wgid % nig) % gsz); u.pn = (wgid % nig) / gsz; return true;
    }
    __device__ __forceinline__ void a_ready(const Unit&) const {}
    __device__ __forceinline__ void done(const Unit&) const {}
};
struct ProjKvOrder {
    StaticOrder so; int G, c;
    __host__ __device__ void init(int G_, int c_) { so.init(16384, 3840, G_, c_); G = G_; c = c_; }
    __host__ __device__ bool next(int i, Unit& u) const {
        if (so.next(i, u)) return true;
        const long kv = (long)i * G + c - so.nwg; if (kv < 0 || kv >= 64) return false;
        u.pm = 64 + (int)(kv & 7); u.pn = 15 + (int)(kv >> 3); return true;
    }
    __device__ __forceinline__ void a_ready(const Unit&) const {}
    __device__ __forceinline__ void done(const Unit&) const {}
};

__device__ __forceinline__ unsigned cvt_pk_bf16(float lo, float hi) { unsigned r; asm volatile("v_cvt_pk_bf16_f32 %0, %1, %2" : "=v"(r) : "v"(lo), "v"(hi)); return r; }
__device__ __forceinline__ float fast_silu(float x) { return x * __builtin_amdgcn_rcpf(1.0f + __builtin_amdgcn_exp2f(-1.4426950408889634f * x)); }
__device__ __forceinline__ u32x4 pack8(const f32x4 a, const f32x4 b) { u32x4 w; w.x = cvt_pk_bf16(a[0], a[1]); w.y = cvt_pk_bf16(a[2], a[3]); w.z = cvt_pk_bf16(b[0], b[1]); w.w = cvt_pk_bf16(b[2], b[3]); return w; }

struct EpiBf16 {
    static constexpr bool PERM = true, AFTER_DRAIN = false;
    bf16_t* O; int ldc;
    __device__ __forceinline__ void operator()(const f32x4 (&acc)[2][2][4][2], const Unit& u, int wr, int wc, int fr, int fq) const {
        const int row0 = u.pm * BM + wr * 64 + fr, col0 = u.pn * BM + wc * 32 + 8 * fq;
#pragma unroll
        for (int ai = 0; ai < 2; ++ai)
#pragma unroll
            for (int m = 0; m < 4; ++m) { bf16_t* rowp = O + (size_t)(row0 + ai * HALF + m * 16) * ldc + col0;
#pragma unroll
                for (int bj = 0; bj < 2; ++bj) *(u32x4*)(rowp + bj * HALF) = pack8(acc[ai][bj][m][0], acc[ai][bj][m][1]); }
    }
};
struct EpiSwiglu {
    static constexpr bool PERM = true, AFTER_DRAIN = false;
    bf16_t* O; int ldc;
    __device__ __forceinline__ void operator()(const f32x4 (&acc)[2][2][4][2], const Unit& u, int wr, int wc, int fr, int fq) const {
        const int row0 = u.pm * BM + wr * 64 + fr, col0 = u.pn * HALF + wc * 32 + 8 * fq;
#pragma unroll
        for (int ai = 0; ai < 2; ++ai)
#pragma unroll
            for (int m = 0; m < 4; ++m) { bf16_t* rowp = O + (size_t)(row0 + ai * HALF + m * 16) * ldc + col0;
                f32x4 h0, h1;
#pragma unroll
                for (int e = 0; e < 4; ++e) { h0[e] = fast_silu(acc[ai][0][m][0][e]) * acc[ai][1][m][0][e]; h1[e] = fast_silu(acc[ai][0][m][1][e]) * acc[ai][1][m][1][e]; }
                *(u32x4*)rowp = pack8(h0, h1); }
    }
};
struct EpiProjKv {
    static constexpr bool PERM = true, AFTER_DRAIN = false;
    bf16_t* P; float* AB; bf16_t* KM; bf16_t* VM;
    __device__ __forceinline__ void operator()(const f32x4 (&acc)[2][2][4][2], const Unit& u, int wr, int wc, int fr, int fq) const {
        if (u.pn < 14) {
            const int row0 = u.pm * BM + wr * 64 + fr, col0 = u.pn * BM + wc * 32 + 8 * fq;
#pragma unroll
            for (int ai = 0; ai < 2; ++ai)
#pragma unroll
                for (int m = 0; m < 4; ++m) { bf16_t* rowp = P + (size_t)(row0 + ai * HALF + m * 16) * 3584 + col0;
#pragma unroll
                    for (int bj = 0; bj < 2; ++bj) *(u32x4*)(rowp + bj * HALF) = pack8(acc[ai][bj][m][0], acc[ai][bj][m][1]); }
        } else if (u.pn == 14) {
            if (wc == 0 && fq == 0) {
                const int row0 = u.pm * BM + wr * 64 + fr;
#pragma unroll
                for (int ai = 0; ai < 2; ++ai)
#pragma unroll
                    for (int m = 0; m < 4; ++m) { float* rowp = AB + (size_t)(row0 + ai * HALF + m * 16) * 8; *(f32x4*)rowp = acc[ai][0][m][0]; *(f32x4*)(rowp + 4) = acc[ai][0][m][1]; }
            }
        } else {
            const int row0 = (u.pm - 64) * BM + wr * 64 + fr; int ct = (u.pn - 15) * BM; bf16_t* base = KM; if (ct >= 1024) { ct -= 1024; base = VM; }
            const int col0 = ct + wc * 32 + 8 * fq;
#pragma unroll
            for (int ai = 0; ai < 2; ++ai)
#pragma unroll
                for (int m = 0; m < 4; ++m) { bf16_t* rowp = base + (size_t)(row0 + ai * HALF + m * 16) * 1024 + col0;
#pragma unroll
                    for (int bj = 0; bj < 2; ++bj) *(u32x4*)(rowp + bj * HALF) = pack8(acc[ai][bj][m][0], acc[ai][bj][m][1]); }
        }
    }
};

template <class Epi, class Sched, bool ALIGN_EPI = false, bool SP2 = false>
__device__ __forceinline__ void gemm_phase(PG8_LAS unsigned char* lds, const Gemm g, const Sched& S, const Epi& E) {
    int tid_ = threadIdx.x; asm volatile("" : "+v"(tid_));
    const int tid = tid_, wid = __builtin_amdgcn_readfirstlane(tid >> 6), lane = tid & 63, wr = wid >> 2, wc = wid & 3, fr = lane & 15, fq = lane >> 4;
    const int K = g.K, nt = K / BK;
    unsigned voffA[2], voffB[2];
#pragma unroll
    for (int i = 0; i < 2; ++i) { int R, C; stage_rc(tid * 16 + i * 8192, R, C); const int Rb = Epi::PERM ? ((R & ~31) + perm32(R & 31)) : R;
        voffA[i] = (unsigned)(R * g.lda + C) * 2u; voffB[i] = (unsigned)(Rb * K + C) * 2u; }
    const size_t kstep = (size_t)(BK * 2);
    const size_t hstepA = (size_t)HALF * g.lda * 2, hstepB = (size_t)HALF * K * 2;
    const size_t tstepA = 2 * hstepA, tstepB = 2 * hstepB;
    const unsigned ldsw = (unsigned)wid * 1024u;
    const int aoff = lds_byte(wr * 64 + fr, fq * 8), boff = lds_byte(wc * 32 + fr, fq * 8);
#define PG8_SA(b, h) (((b) * 2 + (h)) * HTB)
#define PG8_SB(b, h) ((4 + (b) * 2 + (h)) * HTB)
#define PG8_STAGE(bufoff, gbase, voff) do { _Pragma("unroll") for (int _i = 0; _i < 2; ++_i) \
        __builtin_amdgcn_global_load_lds((const unsigned*)((const char*)(gbase) + (voff)[_i]), (PG8_LAS unsigned*)(lds + (bufoff) + ldsw + _i * 8192), 16, 0, 0); } while (0)
#define PG8_LDA(dst, b, h) do { _Pragma("unroll") for (int m = 0; m < 4; ++m) _Pragma("unroll") for (int k = 0; k < 2; ++k) dst[m][k] = *(const PG8_LAS bf16x8*)(lds + PG8_SA(b, h) + aoff + m * 2048 + k * 1024); } while (0)
#define PG8_LDB(dst, b, h) do { _Pragma("unroll") for (int n = 0; n < 2; ++n) _Pragma("unroll") for (int k = 0; k < 2; ++k) dst[n][k] = *(const PG8_LAS bf16x8*)(lds + PG8_SB(b, h) + boff + n * 2048 + k * 1024); } while (0)
#define PG8_MMA(ai, bj, At, Bt) do { __builtin_amdgcn_s_setprio(1); _Pragma("unroll") for (int m = 0; m < 4; ++m) _Pragma("unroll") for (int n = 0; n < 2; ++n) _Pragma("unroll") for (int k = 0; k < 2; ++k) \
        acc[ai][bj][m][n] = __builtin_amdgcn_mfma_f32_16x16x32_bf16(Bt[n][k], At[m][k], acc[ai][bj][m][n], 0, 0, 0); __builtin_amdgcn_s_setprio(0); } while (0)
#define PG8_WAIT_V(n) asm volatile("s_waitcnt vmcnt(" #n ")" ::: "memory")
#define PG8_WAIT_L(n) asm volatile("s_waitcnt lgkmcnt(" #n ")" ::: "memory")
#define PG8_BAR __builtin_amdgcn_s_barrier()
#define PG8_SCHED __builtin_amdgcn_sched_barrier(0)
    Unit cur, nxt; int ui = 0;
    if (!S.next(0, cur)) return;
    f32x4 acc[2][2][4][2];
#pragma unroll
    for (int a = 0; a < 2; ++a)
#pragma unroll
        for (int b = 0; b < 2; ++b)
#pragma unroll
            for (int m = 0; m < 4; ++m)
#pragma unroll
                for (int n = 0; n < 2; ++n) acc[a][b][m][n] = (f32x4){0.f, 0.f, 0.f, 0.f};
    bf16x8 At[4][2], B0[2][2], B1[2][2];
    const char* cA = (const char*)g.A + (size_t)cur.pm * tstepA; const char* cB = (const char*)g.Bt + (size_t)cur.pn * tstepB;
    S.a_ready(cur);
    if constexpr (SP2) {
        PG8_STAGE(PG8_SB(0, 0), cB, voffB); PG8_STAGE(PG8_SB(0, 1), cB + hstepB, voffB); PG8_STAGE(PG8_SA(0, 0), cA, voffA); PG8_STAGE(PG8_SA(0, 1), cA + hstepA, voffA);
        if (wr == 1) PG8_BAR;
        PG8_WAIT_V(2); PG8_BAR;
        PG8_STAGE(PG8_SB(1, 0), cB + kstep, voffB); PG8_STAGE(PG8_SA(1, 0), cA + kstep, voffA); PG8_STAGE(PG8_SB(1, 1), cB + hstepB + kstep, voffB);
        PG8_WAIT_V(6); PG8_BAR;
    } else {
        PG8_STAGE(PG8_SB(0, 0), cB, voffB); PG8_STAGE(PG8_SA(0, 0), cA, voffA); PG8_STAGE(PG8_SB(0, 1), cB + hstepB, voffB); PG8_STAGE(PG8_SA(0, 1), cA + hstepA, voffA);
        if (wr == 1) PG8_BAR;
        PG8_WAIT_V(4); PG8_BAR;
        PG8_STAGE(PG8_SB(1, 0), cB + kstep, voffB); PG8_STAGE(PG8_SA(1, 0), cA + kstep, voffA); PG8_STAGE(PG8_SB(1, 1), cB + hstepB + kstep, voffB);
        PG8_WAIT_V(6); PG8_BAR;
    }
    for (;;) {
        const bool has_next = S.next(ui + 1, nxt);
        const char* nA = has_next ? (const char*)g.A + (size_t)nxt.pm * tstepA : cA; const char* nB = has_next ? (const char*)g.Bt + (size_t)nxt.pn * tstepB : cB;
        for (int t = 0; t < nt; t += 2) {
            const bool last = (t == nt - 2);
            const char* a1 = cA + (size_t)(t + 1) * kstep;
            const char* a2 = last ? nA : cA + (size_t)(t + 2) * kstep; const char* b2 = last ? nB : cB + (size_t)(t + 2) * kstep;
            const char* a3 = a2 + kstep; const char* b3 = b2 + kstep;
            if (last && has_next) S.a_ready(nxt);
            if constexpr (SP2) {
            PG8_LDB(B0, 0, 0); PG8_LDB(B1, 0, 1); PG8_SCHED; PG8_LDA(At, 0, 0); PG8_STAGE(PG8_SA(1, 1), a1 + hstepA, voffA);
            PG8_WAIT_V(8); PG8_WAIT_L(0); PG8_BAR; PG8_MMA(0, 0, At, B0); PG8_MMA(0, 1, At, B1); PG8_BAR; PG8_SCHED;
            PG8_LDA(At, 0, 1); PG8_STAGE(PG8_SB(0, 0), b2, voffB); PG8_STAGE(PG8_SB(0, 1), b2 + hstepB, voffB); PG8_STAGE(PG8_SA(0, 0), a2, voffA);
            PG8_WAIT_V(8); PG8_WAIT_L(0); PG8_BAR; PG8_MMA(1, 0, At, B0); PG8_MMA(1, 1, At, B1); PG8_BAR; PG8_SCHED;
            PG8_LDB(B0, 1, 0); PG8_LDB(B1, 1, 1); PG8_SCHED; PG8_LDA(At, 1, 0); PG8_STAGE(PG8_SA(0, 1), a2 + hstepA, voffA);
            PG8_WAIT_V(8); PG8_WAIT_L(0); PG8_BAR; PG8_MMA(0, 0, At, B0); PG8_MMA(0, 1, At, B1); PG8_BAR; PG8_SCHED;
            PG8_LDA(At, 1, 1); PG8_STAGE(PG8_SB(1, 0), b3, voffB); PG8_STAGE(PG8_SB(1, 1), b3 + hstepB, voffB); PG8_STAGE(PG8_SA(1, 0), a3, voffA);
            PG8_WAIT_V(8); PG8_WAIT_L(0); PG8_BAR; PG8_MMA(1, 0, At, B0); PG8_MMA(1, 1, At, B1); PG8_BAR; PG8_SCHED;
            } else {
            PG8_LDB(B0, 0, 0); PG8_SCHED; PG8_LDA(At, 0, 0); PG8_STAGE(PG8_SA(1, 1), a1 + hstepA, voffA);
            PG8_WAIT_L(8); PG8_BAR; PG8_WAIT_L(0); PG8_MMA(0, 0, At, B0); PG8_BAR; PG8_SCHED;
            PG8_LDB(B1, 0, 1); PG8_STAGE(PG8_SB(0, 0), b2, voffB);
            PG8_BAR; PG8_WAIT_L(0); PG8_MMA(0, 1, At, B1); PG8_BAR;
            PG8_LDA(At, 0, 1); PG8_STAGE(PG8_SA(0, 0), a2, voffA);
            PG8_BAR; PG8_WAIT_L(0); PG8_MMA(1, 0, At, B0); PG8_BAR; PG8_SCHED;
            PG8_STAGE(PG8_SB(0, 1), b2 + hstepB, voffB);
            PG8_WAIT_V(6); PG8_BAR; PG8_MMA(1, 1, At, B1); PG8_BAR;
            PG8_LDB(B0, 1, 0); PG8_SCHED; PG8_LDA(At, 1, 0); PG8_STAGE(PG8_SA(0, 1), a2 + hstepA, voffA);
            PG8_WAIT_L(8); PG8_BAR; PG8_WAIT_L(0); PG8_MMA(0, 0, At, B0); PG8_BAR; PG8_SCHED;
            PG8_LDB(B1, 1, 1); PG8_STAGE(PG8_SB(1, 0), b3, voffB);
            PG8_BAR; PG8_WAIT_L(0); PG8_MMA(0, 1, At, B1); PG8_BAR;
            PG8_LDA(At, 1, 1); PG8_STAGE(PG8_SA(1, 0), a3, voffA);
            PG8_BAR; PG8_WAIT_L(0); PG8_MMA(1, 0, At, B0); PG8_BAR; PG8_SCHED;
            PG8_STAGE(PG8_SB(1, 1), b3 + hstepB, voffB);
            PG8_WAIT_V(6); PG8_BAR; PG8_MMA(1, 1, At, B1); PG8_BAR;
            }
        }
        if constexpr (ALIGN_EPI) { if (wr == 0) PG8_BAR; }
        if constexpr (!Epi::AFTER_DRAIN) { E(acc, cur, wr, wc, fr, fq); S.done(cur); }
        if (!has_next) break;
#pragma unroll
        for (int a = 0; a < 2; ++a)
#pragma unroll
            for (int b = 0; b < 2; ++b)
#pragma unroll
                for (int m = 0; m < 4; ++m)
#pragma unroll
                    for (int n = 0; n < 2; ++n) acc[a][b][m][n] = (f32x4){0.f, 0.f, 0.f, 0.f};
        cur = nxt; cA = nA; cB = nB; ++ui;
        if constexpr (ALIGN_EPI) { if (wr == 1) PG8_BAR; }
    }
    PG8_WAIT_V(0);
    if constexpr (!ALIGN_EPI) { if (wr == 0) PG8_BAR; }
    PG8_BAR;
    if constexpr (Epi::AFTER_DRAIN) { E.fused(acc, cur, wr, wc, fr, fq, lds, wid, lane); S.done(cur); }
#undef PG8_SA
#undef PG8_SB
#undef PG8_STAGE
#undef PG8_LDA
#undef PG8_LDB
#undef PG8_MMA
#undef PG8_WAIT_V
#undef PG8_WAIT_L
#undef PG8_BAR
#undef PG8_SCHED
}
}
#define GAS __attribute__((address_space(1)))
#define LAS __attribute__((address_space(3)))
typedef unsigned short bf16;
typedef unsigned v4u __attribute__((ext_vector_type(4)));
typedef float f32x4 __attribute__((ext_vector_type(4)));
typedef short bf16x8 __attribute__((ext_vector_type(8)));
typedef GAS unsigned gu32;
typedef GAS unsigned long long gu64;
#define RLX_AGENT __ATOMIC_RELAXED, __HIP_MEMORY_SCOPE_AGENT
#define LDS_WAIT() asm volatile("s_waitcnt lgkmcnt(0)" ::: "memory")
#define VM_WAIT() asm volatile("s_waitcnt vmcnt(0)" ::: "memory")
__device__ __forceinline__ unsigned long long rt() { return __builtin_amdgcn_s_memrealtime(); }
__device__ __forceinline__ unsigned f2bf(float f) { unsigned u = __builtin_bit_cast(unsigned, f); return (u + 0x7fffu + ((u >> 16) & 1u)) >> 16; }
__device__ __forceinline__ unsigned pk2(float lo, float hi) { return f2bf(lo) | (f2bf(hi) << 16); }

#define XB_TMO      128
#define XB_XCNT(j)  (256  + 64 * (j))
#define XB_XSUB(j)  (1280 + 64 * (j))
#define XB_XGEN(j)  (2304 + 64 * (j))
#define XB_TOP      3328
#define XB_TOPGEN   3392
#define XCD_BAR_WORDS 3456
#define XB_SPIN_CAP (1u << 18)

__device__ __forceinline__ unsigned xb_ld(unsigned* p)              { return __hip_atomic_load(p, __ATOMIC_RELAXED, __HIP_MEMORY_SCOPE_AGENT); }
__device__ __forceinline__ unsigned xb_add(unsigned* p, unsigned v) { return __hip_atomic_fetch_add(p, v, __ATOMIC_RELAXED, __HIP_MEMORY_SCOPE_AGENT); }
__device__ __forceinline__ unsigned xb_xcc_id() { return (unsigned)__builtin_amdgcn_s_getreg((3 << 11) | 20) & 0xFu; }
#define XB_SPIN(cond, bar) do { unsigned _sp = 0; while (cond) { __builtin_amdgcn_s_sleep(1); \
    if ((++_sp & 255u) == 0u) { if (xb_ld(&(bar)[XB_TMO])) break; if (_sp > XB_SPIN_CAP) { atomicAdd(&(bar)[XB_TMO], 1u); break; } } } } while (0)

struct XcdBarrier {
    unsigned* bar; unsigned x;
    volatile LAS unsigned* st;
};

__device__ __forceinline__ XcdBarrier xcd_barrier_post(unsigned* bar, volatile LAS unsigned* st) {
    XcdBarrier b; b.bar = bar; b.x = xb_xcc_id(); b.st = st;
    if (threadIdx.x == 0) (void)xb_add(&bar[XB_XCNT(b.x)], 1u);
    return b;
}
__device__ __forceinline__ void xcd_barrier_complete(unsigned* bar, unsigned x, unsigned& nloc, unsigned& nx) {
    const unsigned G = gridDim.x * gridDim.y * gridDim.z;
    unsigned sum, cnt, mine, sp = 0u;
    for (;;) {
        sum = 0u; cnt = 0u; mine = 0u;
#pragma unroll
        for (unsigned j = 0; j < 16; ++j) { const unsigned c = xb_ld(&bar[XB_XCNT(j)]); sum += c; cnt += (c > 0u) ? 1u : 0u; mine = (j == x) ? c : mine; }
        if (sum == G) break;
        __builtin_amdgcn_s_sleep(1);
        if ((++sp & 255u) == 0u) { if (xb_ld(&bar[XB_TMO])) break; if (sp > XB_SPIN_CAP) { atomicAdd(&bar[XB_TMO], 1u); break; } }
    }
    nloc = mine > 0u ? mine : 1u; nx = cnt > 0u ? cnt : 1u;
}

__device__ __forceinline__ void xcd_barrier(const XcdBarrier& b) {
    asm volatile("s_waitcnt vmcnt(0)" ::: "memory");
    __syncthreads();
    if (threadIdx.x == 0) {
        unsigned* bar = b.bar;
        __builtin_amdgcn_s_waitcnt(0);
        unsigned nloc = b.st[0], nx = b.st[1];
        if (nloc == 0u) { xcd_barrier_complete(bar, b.x, nloc, nx); b.st[0] = nloc; b.st[1] = nx; }
        const unsigned old = xb_add(&bar[XB_XSUB(b.x)], 1u);
        const unsigned gen = old / nloc;
        if (old + 1u == (gen + 1u) * nloc) {
            __builtin_amdgcn_fence(__ATOMIC_RELEASE, "agent");
            asm volatile("s_waitcnt vmcnt(0)" ::: "memory");
            const unsigned og = xb_add(&bar[XB_TOP], 1u);
            const unsigned tg = og / nx;
            if (og + 1u == (tg + 1u) * nx) xb_add(&bar[XB_TOPGEN], 1u);
            else XB_SPIN(xb_ld(&bar[XB_TOPGEN]) == tg, bar);
            __builtin_amdgcn_fence(__ATOMIC_ACQUIRE, "agent");
            xb_add(&bar[XB_XGEN(b.x)], 1u);
            asm volatile("s_waitcnt vmcnt(0)" ::: "memory");
        } else {
            XB_SPIN(xb_ld(&bar[XB_XGEN(b.x)]) == gen, bar);
            __builtin_amdgcn_fence(__ATOMIC_ACQUIRE, "agent");
            asm volatile("s_waitcnt vmcnt(0)" ::: "memory");
        }
    }
    __syncthreads();
}

constexpr int NWAVES = 8, NTHREADS = 512;
constexpr int DM = 1024, NBATCH = 8, SEQ = 2048, MTOK = NBATCH * SEQ, NMEM = 256, MMEM = NBATCH * NMEM, DFF = 2816, INC = 3592;
constexpr int PW = 3584;
constexpr float EPS = 1e-6f;
constexpr size_t MiB = 1u << 20;
constexpr size_t WS_CTL = 0, CTL_ZERO_BYTES = 1 * MiB;
constexpr size_t WS_W1GU = 1 * MiB, WS_W1D = 12 * MiB, WS_WIN = 35 * MiB / 2, WS_WKV = 25 * MiB, WS_WOUT = 29 * MiB, WS_WQ = 31 * MiB, WS_WO = 33 * MiB, WS_W2GU = 35 * MiB, WS_W2D = 46 * MiB;
constexpr size_t WS_XN = 52 * MiB;
constexpr size_t WS_QN = 52 * MiB, WS_KN = 68 * MiB;
constexpr size_t WS_BIG = 88 * MiB;
constexpr size_t WS_HB = 88 * MiB;
constexpr size_t WS_PROJ = 88 * MiB;
constexpr size_t WS_Q = 88 * MiB;
constexpr size_t WS_T1 = 200 * MiB;
constexpr size_t WS_VV = 200 * MiB;
constexpr size_t WS_AB = 232 * MiB, WS_BETA = 233 * MiB, WS_GG = 234 * MiB;
constexpr size_t WS_CWN = 1 * MiB, WS_CQK = 17 * MiB, WS_CU = 52 * MiB, WS_CQD = 200 * MiB, WS_CKDT = 216 * MiB, WS_GL = 235 * MiB;
constexpr size_t WS_KM = 240 * MiB, WS_VM = 244 * MiB, WS_END = 248 * MiB;
static_assert(WS_WIN + (size_t)3840 * 1024 * 2 == WS_WKV, "Wkv rows must directly follow Win rows");
constexpr int CW_BAR = 4096;
constexpr int RING_OFF = 0, RING_BYTES = 131072, LDSCTL_OFF = RING_BYTES, MISC_OFF = LDSCTL_OFF + 320, LDS_BYTES = 147456;

struct Frame {
    LAS unsigned char* lds; volatile LAS unsigned* MISC; gu32* ctl;
    int tid, lane, wave, vcu, G;
};
__device__ __forceinline__ float wave_sum(float v) {
#pragma unroll
    for (int o = 1; o < 64; o <<= 1) v += __shfl_xor(v, o);
    return v;
}
__device__ __forceinline__ float wave_max(float v) {
#pragma unroll
    for (int o = 1; o < 64; o <<= 1) v = fmaxf(v, __shfl_xor(v, o));
    return v;
}
__device__ __forceinline__ float bf2f(unsigned short b) { return __uint_as_float((unsigned)b << 16); }
__device__ __forceinline__ float bflo(unsigned w) { return __uint_as_float(w << 16); }
__device__ __forceinline__ float bfhi(unsigned w) { return __uint_as_float(w & 0xffff0000u); }
__device__ __forceinline__ float silu_f(float x) { return x / (1.f + __expf(-x)); }

__device__ __forceinline__ void transpose_item(const float* W, int ldw, int K, int k0, int srcbase, int nvalid, bf16* WT, int dstrow0, LAS float* scr, int lane) {
    const int nl = lane & 31; const bool ok = nl < nvalid;
#pragma unroll 8
    for (int i = 0; i < 32; ++i) { const int kk = 2 * i + (lane >> 5); scr[kk * 33 + nl] = ok ? W[(size_t)(k0 + kk) * ldw + srcbase + nl] : 0.f; }
    LDS_WAIT(); asm volatile("" ::: "memory");
    const int c = lane & 7;
#pragma unroll
    for (int j = 0; j < 4; ++j) { const int n = (lane >> 3) + 8 * j; const LAS float* s = scr + (8 * c) * 33 + n;
        v4u o; o.x = pk2(s[0 * 33], s[1 * 33]); o.y = pk2(s[2 * 33], s[3 * 33]); o.z = pk2(s[4 * 33], s[5 * 33]); o.w = pk2(s[6 * 33], s[7 * 33]);
        *(GAS v4u*)(WT + (size_t)(dstrow0 + n) * K + k0 + 8 * c) = o; }
    LDS_WAIT(); asm volatile("" ::: "memory");
}
__device__ __forceinline__ void conv_gu(const float* wg, const float* wu, bf16* WT, LAS float* scr, int it, int lane) {
    const int which = it / 1408, r = it % 1408, kb = r / 88, nb = r % 88, n0 = nb * 32;
    transpose_item(which ? wu : wg, DFF, DM, kb * 64, n0, 32, WT, 256 * (n0 >> 7) + (which ? 128 : 0) + (n0 & 127), scr, lane);
}
__device__ __forceinline__ void conv_plain(const float* w, int K, int N, bf16* WT, int rowoff, LAS float* scr, int it, int lane) {
    const int nblk = N / 32, kb = it / nblk, nb = it % nblk;
    transpose_item(w, N, K, kb * 64, nb * 32, 32, WT, rowoff + nb * 32, scr, lane);
}
__device__ __forceinline__ void conv_win(const float* w, bf16* WT, LAS float* scr, int it, int lane) {
    const int kb = it / 120, db = it % 120, d0 = db * 32;
    int srcbase = d0, nvalid = 32;
    if (d0 >= 2048 && d0 < 3584) srcbase = d0 + 8; else if (d0 == 3584) { srcbase = 2048; nvalid = 8; } else if (d0 > 3584) { srcbase = 0; nvalid = 0; }
    transpose_item(w, INC, DM, kb * 64, srcbase, nvalid, WT, d0, scr, lane);
}
__device__ __forceinline__ void norm_row_bf16(const float* xrow, const float* g, bf16* orow, int lane) {
    const GAS f32x4* xr = (const GAS f32x4*)xrow + lane; const GAS f32x4* gr = (const GAS f32x4*)g + lane;
    f32x4 v[4]; float s = 0.f;
#pragma unroll
    for (int j = 0; j < 4; ++j) { v[j] = xr[64 * j]; s += (v[j].x * v[j].x + v[j].y * v[j].y) + (v[j].z * v[j].z + v[j].w * v[j].w); }
    const float r = rsqrtf(wave_sum(s) * (1.f / DM) + EPS);
    GAS unsigned long long* o8 = (GAS unsigned long long*)orow + lane;
#pragma unroll
    for (int j = 0; j < 4; ++j) { const f32x4 gg = gr[64 * j]; o8[64 * j] = (unsigned long long)pk2(v[j].x * r * gg.x, v[j].y * r * gg.y) | ((unsigned long long)pk2(v[j].z * r * gg.z, v[j].w * r * gg.w) << 32); }
}
__device__ __forceinline__ const float* inptr(int i) { const char* ka = (const char*)__builtin_amdgcn_kernarg_segment_ptr(); int off = i * 8; asm volatile("" : "+s"(off)); return *(const float* const*)(ka + off); }
#define INP(i) inptr(i)
__device__ __forceinline__ void p0_prologue(Frame& F, unsigned char* ws) {
    LAS float* scr = (LAS float*)(F.lds + RING_OFF + F.wave * 16384);
    const int gw = F.vcu * NWAVES + F.wave, NGW = F.G * NWAVES;
    constexpr int I_GU = 2 * 16 * 88, I_D = 44 * 32, I_IN = 16 * 120, I_SQ = 16 * 32;
    constexpr int NITEMS = 2 * I_GU + 2 * I_D + I_IN + 5 * I_SQ;
    for (int it = gw; it < NITEMS; it += NGW) {
        int r = it;
        if (r < I_GU) { conv_gu(INP(3), INP(4), (bf16*)(ws + WS_W1GU), scr, r, F.lane); continue; } r -= I_GU;
        if (r < I_D) { conv_plain(INP(5), DFF, DM, (bf16*)(ws + WS_W1D), 0, scr, r, F.lane); continue; } r -= I_D;
        if (r < I_IN) { conv_win(INP(8), (bf16*)(ws + WS_WIN), scr, r, F.lane); continue; } r -= I_IN;
        if (r < I_SQ) { conv_plain(INP(18), DM, DM, (bf16*)(ws + WS_WKV), 0, scr, r, F.lane); continue; } r -= I_SQ;
        if (r < I_SQ) { conv_plain(INP(19), DM, DM, (bf16*)(ws + WS_WKV), 1024, scr, r, F.lane); continue; } r -= I_SQ;
        if (r < I_SQ) { conv_plain(INP(13), DM, DM, (bf16*)(ws + WS_WOUT), 0, scr, r, F.lane); continue; } r -= I_SQ;
        if (r < I_SQ) { conv_plain(INP(17), DM, DM, (bf16*)(ws + WS_WQ), 0, scr, r, F.lane); continue; } r -= I_SQ;
        if (r < I_SQ) { conv_plain(INP(20), DM, DM, (bf16*)(ws + WS_WO), 0, scr, r, F.lane); continue; } r -= I_SQ;
        if (r < I_GU) { conv_gu(INP(23), INP(24), (bf16*)(ws + WS_W2GU), scr, r, F.lane); continue; } r -= I_GU;
        conv_plain(INP(25), DFF, DM, (bf16*)(ws + WS_W2D), 0, scr, r, F.lane);
    }
    bf16* XN = (bf16*)(ws + WS_XN);
    for (int m = gw; m < MTOK + MMEM; m += NGW) {
        if (m < MTOK) norm_row_bf16(INP(0) + (size_t)m * DM, INP(2), XN + (size_t)m * DM, F.lane);
        else norm_row_bf16(INP(1) + (size_t)(m - MTOK) * DM, INP(16), XN + (size_t)m * DM, F.lane);
    }
}
__device__ __forceinline__ void norm_pass(Frame& F, const float* xin, const bf16* f, const float* g1, float scale, float* xout, const float* g2, bf16* XN) {
    const int gw = F.vcu * NWAVES + F.wave, NGW = F.G * NWAVES;
    for (int m = gw; m < MTOK; m += NGW) {
        const GAS f32x4* xr = (const GAS f32x4*)(xin + (size_t)m * DM) + F.lane;
        const GAS unsigned long long* fr = (const GAS unsigned long long*)(f + (size_t)m * DM) + F.lane;
        const GAS f32x4* g1r = (const GAS f32x4*)g1 + F.lane;
        f32x4 fv[4]; float s = 0.f;
#pragma unroll
        for (int j = 0; j < 4; ++j) { const unsigned long long w = fr[64 * j]; const unsigned lo = (unsigned)w, hi = (unsigned)(w >> 32);
            fv[j] = (f32x4){bflo(lo), bfhi(lo), bflo(hi), bfhi(hi)}; s += (fv[j].x * fv[j].x + fv[j].y * fv[j].y) + (fv[j].z * fv[j].z + fv[j].w * fv[j].w); }
        const float r1 = rsqrtf(wave_sum(s) * (1.f / DM) + EPS) * scale;
        float s2 = 0.f;
        GAS f32x4* xo = (GAS f32x4*)(xout + (size_t)m * DM) + F.lane;
#pragma unroll
        for (int j = 0; j < 4; ++j) { const f32x4 xx = xr[64 * j]; const f32x4 gg = g1r[64 * j];
            fv[j] = xx + fv[j] * gg * r1; s2 += (fv[j].x * fv[j].x + fv[j].y * fv[j].y) + (fv[j].z * fv[j].z + fv[j].w * fv[j].w); xo[64 * j] = fv[j]; }
        if (g2) {
            const float r2 = rsqrtf(wave_sum(s2) * (1.f / DM) + EPS);
            const GAS f32x4* g2r = (const GAS f32x4*)g2 + F.lane;
            GAS unsigned long long* o8 = (GAS unsigned long long*)(XN + (size_t)m * DM) + F.lane;
#pragma unroll
            for (int j = 0; j < 4; ++j) { const f32x4 gg = g2r[64 * j]; o8[64 * j] = (unsigned long long)pk2(fv[j].x * r2 * gg.x, fv[j].y * r2 * gg.y) | ((unsigned long long)pk2(fv[j].z * r2 * gg.z, fv[j].w * r2 * gg.w) << 32); }
        }
    }
}
__device__ __forceinline__ void swa_naive(Frame& F, bf16* P, int wg, int nwg) {
    for (int idx = wg * NTHREADS + F.tid; idx < MTOK * 8; idx += nwg * NTHREADS) {
        const int t = idx & (SEQ - 1), h = (idx >> 11) & 7, b = idx >> 14;
        const float slope = exp2f(-(float)(h + 1));
        const bf16* base = P + (size_t)b * SEQ * PW;
        float q[64], o[64];
        { const v4u* qp = (const v4u*)(base + (size_t)t * PW + 2048 + h * 64);
#pragma unroll
          for (int i = 0; i < 8; ++i) { const v4u w = qp[i]; q[8 * i] = bflo(w.x); q[8 * i + 1] = bfhi(w.x); q[8 * i + 2] = bflo(w.y); q[8 * i + 3] = bfhi(w.y); q[8 * i + 4] = bflo(w.z); q[8 * i + 5] = bfhi(w.z); q[8 * i + 6] = bflo(w.w); q[8 * i + 7] = bfhi(w.w); } }
#pragma unroll
        for (int i = 0; i < 64; ++i) o[i] = 0.f;
        float m = -INFINITY, l = 0.f;
        for (int br = 0; br < 3; ++br) {
            const int dil = (br == 0) ? 1 : (br == 1 ? 4 : 16);
            for (int dl = 0; dl <= 128; ++dl) {
                const int tk = t - dl * dil;
                if (tk < 0) break;
                const v4u* kp = (const v4u*)(base + (size_t)tk * PW + 2560 + h * 64);
                float s = 0.f;
#pragma unroll
                for (int i = 0; i < 8; ++i) { const v4u w = kp[i];
                    s = fmaf(q[8 * i], bflo(w.x), s); s = fmaf(q[8 * i + 1], bfhi(w.x), s); s = fmaf(q[8 * i + 2], bflo(w.y), s); s = fmaf(q[8 * i + 3], bfhi(w.y), s);
                    s = fmaf(q[8 * i + 4], bflo(w.z), s); s = fmaf(q[8 * i + 5], bfhi(w.z), s); s = fmaf(q[8 * i + 6], bflo(w.w), s); s = fmaf(q[8 * i + 7], bfhi(w.w), s); }
                s = s * 0.125f - slope * (float)(dil * dl);
                const float mn = fmaxf(m, s);
                const float c = __expf(m - mn), p = __expf(s - mn);
                l = l * c + p; m = mn;
                const v4u* vp = (const v4u*)(base + (size_t)tk * PW + 3072 + h * 64);
#pragma unroll
                for (int i = 0; i < 8; ++i) { const v4u w = vp[i];
                    o[8 * i] = o[8 * i] * c + p * bflo(w.x); o[8 * i + 1] = o[8 * i + 1] * c + p * bfhi(w.x); o[8 * i + 2] = o[8 * i + 2] * c + p * bflo(w.y); o[8 * i + 3] = o[8 * i + 3] * c + p * bfhi(w.y);
                    o[8 * i + 4] = o[8 * i + 4] * c + p * bflo(w.z); o[8 * i + 5] = o[8 * i + 5] * c + p * bfhi(w.z); o[8 * i + 6] = o[8 * i + 6] * c + p * bflo(w.w); o[8 * i + 7] = o[8 * i + 7] * c + p * bfhi(w.w); }
            }
        }
        const float il = 1.f / l;
        v4u* op = (v4u*)(P + ((size_t)b * SEQ + t) * PW + 512 + h * 64);
#pragma unroll
        for (int i = 0; i < 8; ++i) { v4u w; w.x = pk2(o[8 * i] * il, o[8 * i + 1] * il); w.y = pk2(o[8 * i + 2] * il, o[8 * i + 3] * il); w.z = pk2(o[8 * i + 4] * il, o[8 * i + 5] * il); w.w = pk2(o[8 * i + 6] * il, o[8 * i + 7] * il); op[i] = w; }
    }
}
__device__ __forceinline__ void xattn_naive(Frame& F, const bf16* Q, const bf16* KM, const bf16* VM, bf16* O) {
    LAS float* qs = (LAS float*)F.lds;
    LAS float* ps = qs + 2048;
    const int tid = F.tid, w = F.wave, lane = F.lane, rr = w >> 2, hd = w & 3;
    for (int rp = F.vcu; rp < MTOK / 2; rp += F.G) {
        const size_t row0 = (size_t)rp * 2;
        { const unsigned long long wq = *(const unsigned long long*)(Q + row0 * DM + tid * 4); const unsigned lo = (unsigned)wq, hi = (unsigned)(wq >> 32);
          qs[tid * 4] = bflo(lo); qs[tid * 4 + 1] = bfhi(lo); qs[tid * 4 + 2] = bflo(hi); qs[tid * 4 + 3] = bfhi(hi); }
        __syncthreads();
        const size_t row = row0 + rr; const int b = (int)(row >> 11);
        float sc[4];
#pragma unroll
        for (int i = 0; i < 4; ++i) {
            const int mk = lane + 64 * i;
            const v4u* kp = (const v4u*)(KM + ((size_t)b * NMEM + mk) * DM + hd * 256);
            const LAS float* qq = qs + rr * 1024 + hd * 256;
            float s = 0.f;
            for (int d8 = 0; d8 < 32; ++d8) { const v4u kw = kp[d8];
                s = fmaf(qq[8 * d8], bflo(kw.x), s); s = fmaf(qq[8 * d8 + 1], bfhi(kw.x), s); s = fmaf(qq[8 * d8 + 2], bflo(kw.y), s); s = fmaf(qq[8 * d8 + 3], bfhi(kw.y), s);
                s = fmaf(qq[8 * d8 + 4], bflo(kw.z), s); s = fmaf(qq[8 * d8 + 5], bfhi(kw.z), s); s = fmaf(qq[8 * d8 + 6], bflo(kw.w), s); s = fmaf(qq[8 * d8 + 7], bfhi(kw.w), s); }
            sc[i] = s * 0.0625f;
        }
        const float mx = wave_max(fmaxf(fmaxf(sc[0], sc[1]), fmaxf(sc[2], sc[3])));
        float e[4]; float sum = 0.f;
#pragma unroll
        for (int i = 0; i < 4; ++i) { e[i] = __expf(sc[i] - mx); sum += e[i]; }
        const float inv = 1.f / wave_sum(sum);
#pragma unroll
        for (int i = 0; i < 4; ++i) ps[w * 256 + lane + 64 * i] = e[i] * inv;
        __syncthreads();
        float a0 = 0.f, a1 = 0.f, a2 = 0.f, a3 = 0.f;
        for (int mk = 0; mk < NMEM; ++mk) {
            const float p = ps[w * 256 + mk];
            const unsigned long long vw = *(const unsigned long long*)(VM + ((size_t)b * NMEM + mk) * DM + hd * 256 + lane * 4); const unsigned lo = (unsigned)vw, hi = (unsigned)(vw >> 32);
            a0 = fmaf(p, bflo(lo), a0); a1 = fmaf(p, bfhi(lo), a1); a2 = fmaf(p, bflo(hi), a2); a3 = fmaf(p, bfhi(hi), a3);
        }
        *(unsigned long long*)(O + row * DM + hd * 256 + lane * 4) = (unsigned long long)pk2(a0, a1) | ((unsigned long long)pk2(a2, a3) << 32);
        __syncthreads();
    }
}

typedef short s16x8 __attribute__((ext_vector_type(8)));
typedef unsigned u32x2v __attribute__((ext_vector_type(2)));
__device__ __forceinline__ f32x4 mma16(s16x8 a, s16x8 b, f32x4 c) { return __builtin_amdgcn_mfma_f32_16x16x32_bf16(a, b, c, 0, 0, 0); }
__device__ __forceinline__ s16x8 pack8f(const f32x4 a, const f32x4 b) { v4u w; w.x = pk2(a[0], a[1]); w.y = pk2(a[2], a[3]); w.z = pk2(b[0], b[1]); w.w = pk2(b[2], b[3]); return __builtin_bit_cast(s16x8, w); }
#define LDS_BAR() do { asm volatile("s_waitcnt vmcnt(0) lgkmcnt(0)" ::: "memory"); __builtin_amdgcn_s_barrier(); asm volatile("" ::: "memory"); } while (0)
constexpr int CK_QB = 0, CK_KB = 17408, CK_KT = 34816, CK_VBT = 53248, CK_KBET = 71680, CK_AT = 90112, CK_TB = 107520, CK_TAB = 116736, CK_LR = 117760, CK_T0T = 120320;
__device__ __forceinline__ void gdn_chunk(Frame& F, const bf16* P, const float* AB, const float* convw, const float* a_log, const float* dt_bias,
                                          bf16* WN, bf16* QD, bf16* KDT, bf16* QK, float* U, float* GL) {
    LAS unsigned char* L = F.lds;
    LAS float* tab = (LAS float*)(L + CK_TAB);
    const int w = F.wave;
    for (int item = F.vcu; item < NBATCH * 4 * 32; item += F.G) {
        int lane = F.lane; asm volatile("" : "+v"(lane));
        int li = lane & 15, lg = lane >> 4;
        const int n = item & 31, bh = item >> 5, h = bh & 3, b = bh >> 2;
        const size_t row0 = (size_t)b * SEQ + (size_t)n * 64;
        if (w == 0) {
            const float a = AB[(row0 + lane) * 8 + h], bb = AB[(row0 + lane) * 8 + 4 + h];
            const float xx = a + dt_bias[h];
            const float gt = -expf(a_log[h]) * ((xx > 20.f) ? xx : log1pf(expf(xx)));
            float gc = gt;
#pragma unroll
            for (int o = 1; o < 64; o <<= 1) { const float tv = __shfl_up(gc, o); if (lane >= o) gc += tv; }
            const float gl = __shfl(gc, 63);
            tab[lane] = gc; tab[64 + lane] = 1.f / (1.f + expf(-bb)); tab[128 + lane] = expf(gc); tab[192 + lane] = expf(gl - gc);
            if (lane == 63) GL[item] = expf(gc);
        }
        LDS_BAR();
        {
            float cq[4][2], ck[4][2], cv[4][2];
#pragma unroll
            for (int j = 0; j < 4; ++j)
#pragma unroll
                for (int e = 0; e < 2; ++e) { const int c = h * 128 + lane + 64 * e; cq[j][e] = convw[j * 1536 + c]; ck[j][e] = convw[j * 1536 + 512 + c]; cv[j][e] = convw[j * 1536 + 1024 + c]; }
#pragma unroll 1
            for (int tt = 0; tt < 8; ++tt) {
                const int t = 8 * w + tt, tseq = n * 64 + t;
                float yq[2] = {0.f, 0.f}, yk[2] = {0.f, 0.f}, yv[2] = {0.f, 0.f};
#pragma unroll
                for (int j = 0; j < 4; ++j) {
                    if (tseq - 3 + j >= 0) {
                        const bf16* r = P + (row0 + t - 3 + j) * PW + h * 128 + lane;
#pragma unroll
                        for (int e = 0; e < 2; ++e) { yq[e] += cq[j][e] * bf2f(r[64 * e]); yk[e] += ck[j][e] * bf2f(r[512 + 64 * e]); yv[e] += cv[j][e] * bf2f(r[1024 + 64 * e]); }
                    }
                }
#pragma unroll
                for (int e = 0; e < 2; ++e) { yq[e] = silu_f(yq[e]); yk[e] = silu_f(yk[e]); yv[e] = silu_f(yv[e]); }
                const float rq = rsqrtf(wave_sum(yq[0] * yq[0] + yq[1] * yq[1]) + EPS) * 0.08838834764831845f;
                const float rk = rsqrtf(wave_sum(yk[0] * yk[0] + yk[1] * yk[1]) + EPS);
                const float bt = tab[64 + t], egt = tab[128 + t];
#pragma unroll
                for (int e = 0; e < 2; ++e) {
                    const int d = lane + 64 * e; const float qn = yq[e] * rq, kn = yk[e] * rk;
                    *(LAS unsigned short*)(L + CK_QB + t * 272 + 2 * d) = (unsigned short)f2bf(qn);
                    *(LAS unsigned short*)(L + CK_KB + t * 272 + 2 * d) = (unsigned short)f2bf(kn);
                    *(LAS unsigned short*)(L + CK_KT + d * 144 + 2 * t) = (unsigned short)f2bf(kn);
                    *(LAS unsigned short*)(L + CK_VBT + d * 144 + 2 * t) = (unsigned short)f2bf(yv[e] * bt);
                    *(LAS unsigned short*)(L + CK_KBET + d * 144 + 2 * t) = (unsigned short)f2bf(kn * bt * egt);
                }
            }
        }
        LDS_BAR();
        asm volatile("" : "+v"(lane)); li = lane & 15; lg = lane >> 4;
        if (w < 6) {
            const int mblk = (w < 3) ? w : (w < 5 ? 2 + ((w - 3) >> 1) * 0 : 3);
            const int mb2 = (w == 3) ? 2 : (w >= 4 ? 3 : w);
            const int s = (w == 3 || w == 5) ? 1 : 0;
            (void)mblk;
            f32x4 kk[2], qk[2];
#pragma unroll
            for (int hf = 0; hf < 2; ++hf) { kk[hf] = (f32x4){0.f, 0.f, 0.f, 0.f}; qk[hf] = (f32x4){0.f, 0.f, 0.f, 0.f}; }
#pragma unroll
            for (int hf = 0; hf < 2; ++hf) {
                const int cb = 2 * s + hf;
                if (cb <= mb2) {
#pragma unroll
                    for (int ks = 0; ks < 4; ++ks) {
                        const s16x8 a = *(const LAS s16x8*)(L + CK_KB + (16 * cb + li) * 272 + 64 * ks + 16 * lg);
                        const s16x8 bk = *(const LAS s16x8*)(L + CK_KB + (16 * mb2 + li) * 272 + 64 * ks + 16 * lg);
                        const s16x8 bq = *(const LAS s16x8*)(L + CK_QB + (16 * mb2 + li) * 272 + 64 * ks + 16 * lg);
                        kk[hf] = mma16(a, bk, kk[hf]); qk[hf] = mma16(a, bq, qk[hf]);
                    }
                }
            }
            const int i = 16 * mb2 + li; const float gci = tab[i], bi = tab[64 + i];
            f32x4 qv[2];
#pragma unroll
            for (int hf = 0; hf < 2; ++hf) {
                const int cb = 2 * s + hf;
#pragma unroll
                for (int r = 0; r < 4; ++r) {
                    const int j = 16 * cb + 4 * lg + r;
                    const float dec = __expf(fminf(gci - tab[j], 0.f));
                    qv[hf][r] = (i >= j) ? qk[hf][r] * dec : 0.f;
                    kk[hf][r] = (i > j) ? bi * kk[hf][r] * dec : 0.f;
                    if (cb <= mb2) *(LAS float*)(L + CK_AT + j * 272 + 4 * i) = kk[hf][r];
                }
                if (mb2 >= 2 && s == 0) { u32x2v o; o.x = pk2(kk[hf][0], kk[hf][1]); o.y = pk2(kk[hf][2], kk[hf][3]); *(LAS u32x2v*)(L + CK_LR + (i - 32) * 80 + (16 * cb + 4 * lg) * 2) = o; }
            }
            *(GAS v4u*)(QK + ((size_t)item * 8 + mb2 * 2 + s) * 512 + lane * 8) = __builtin_bit_cast(v4u, pack8f(qv[0], qv[1]));
        } else {
            *(GAS v4u*)(QK + ((size_t)item * 8 + (w == 6 ? 1 : 3)) * 512 + lane * 8) = (v4u){0u, 0u, 0u, 0u};
        }
        LDS_BAR();
        asm volatile("" : "+v"(lane)); li = lane & 15; lg = lane >> 4;
        if (w == 0) {
            const int half = lane >> 5, rl = lane & 31, base = 32 * half;
            float T[32];
#pragma unroll
            for (int j = 0; j < 32; ++j) T[j] = (j == rl) ? 1.f : 0.f;
#pragma unroll
            for (int c = 30; c >= 0; --c) {
                float a0 = 0.f, a1 = 0.f, a2 = 0.f, a3 = 0.f;
                unsigned aoff = (unsigned)(CK_AT + (base + c) * 272 + base * 4);
                if (c + 3 <= 31) asm volatile("" : "+v"(aoff) : "v"(T[c + 3]));
                const LAS float* ar = (const LAS float*)(L + aoff);
#pragma unroll
                for (int j4 = ((c + 1) >> 2); j4 < 8; ++j4) {
                    const f32x4 av = *(const LAS f32x4*)(ar + 4 * j4);
                    if (4 * j4 + 0 > c) a0 = fmaf(T[4 * j4 + 0], av[0], a0);
                    if (4 * j4 + 1 > c) a1 = fmaf(T[4 * j4 + 1], av[1], a1);
                    if (4 * j4 + 2 > c) a2 = fmaf(T[4 * j4 + 2], av[2], a2);
                    if (4 * j4 + 3 > c) a3 = fmaf(T[4 * j4 + 3], av[3], a3);
                }
                T[c] = (rl == c) ? 1.f : -((a0 + a1) + (a2 + a3));
            }
#pragma unroll
            for (int k8 = 0; k8 < 4; ++k8) {
                v4u o; o.x = pk2(T[8 * k8], T[8 * k8 + 1]); o.y = pk2(T[8 * k8 + 2], T[8 * k8 + 3]); o.z = pk2(T[8 * k8 + 4], T[8 * k8 + 5]); o.w = pk2(T[8 * k8 + 6], T[8 * k8 + 7]);
                *(LAS v4u*)(L + CK_TB + lane * 144 + 2 * base + 16 * k8) = o;
            }
            if (half == 0) {
#pragma unroll
                for (int k8 = 0; k8 < 4; ++k8) *(LAS v4u*)(L + CK_TB + lane * 144 + 64 + 16 * k8) = (v4u){0u, 0u, 0u, 0u};
#pragma unroll
                for (int c = 0; c < 32; ++c) *(LAS unsigned short*)(L + CK_T0T + c * 80 + 2 * rl) = (unsigned short)f2bf(T[c]);
            }
            asm volatile("s_waitcnt lgkmcnt(0)" ::: "memory");
            s16x8 lr[2], t0[2];
#pragma unroll
            for (int q = 0; q < 2; ++q) { lr[q] = *(const LAS s16x8*)(L + CK_LR + (16 * q + li) * 80 + 16 * lg); t0[q] = *(const LAS s16x8*)(L + CK_T0T + (16 * q + li) * 80 + 16 * lg); }
            s16x8 xb[2];
#pragma unroll
            for (int jb = 0; jb < 2; ++jb) { const f32x4 z4 = (f32x4){0.f, 0.f, 0.f, 0.f}; const f32x4 x0 = mma16(lr[0], t0[jb], z4), x1 = mma16(lr[1], t0[jb], z4); xb[jb] = pack8f(x0, x1); }
#pragma unroll
            for (int ib = 0; ib < 2; ++ib) {
                const u32x2v lo = *(const LAS u32x2v*)(L + CK_TB + (32 + 16 * ib + li) * 144 + (32 + 4 * lg) * 2), hi = *(const LAS u32x2v*)(L + CK_TB + (32 + 16 * ib + li) * 144 + (48 + 4 * lg) * 2);
                const s16x8 a = __builtin_bit_cast(s16x8, (v4u){lo.x, lo.y, hi.x, hi.y});
#pragma unroll
                for (int jb = 0; jb < 2; ++jb) { const f32x4 d = mma16(a, xb[jb], (f32x4){0.f, 0.f, 0.f, 0.f});
#pragma unroll
                    for (int r = 0; r < 4; ++r) *(LAS unsigned short*)(L + CK_TB + (32 + 16 * ib + 4 * lg + r) * 144 + 2 * (16 * jb + li)) = (unsigned short)f2bf(-d[r]); }
            }
        } else {
            for (int f = w - 1; f < 32; f += 7) {
                if (f < 16) {
                    const int mblk = f >> 2, s = f & 3, i = 16 * mblk + li; const float e = tab[128 + i];
                    const u32x2v lo = *(const LAS u32x2v*)(L + CK_QB + i * 272 + (32 * s + 4 * lg) * 2), hi = *(const LAS u32x2v*)(L + CK_QB + i * 272 + (32 * s + 16 + 4 * lg) * 2);
                    v4u o; o.x = pk2(bflo(lo.x) * e, bfhi(lo.x) * e); o.y = pk2(bflo(lo.y) * e, bfhi(lo.y) * e); o.z = pk2(bflo(hi.x) * e, bfhi(hi.x) * e); o.w = pk2(bflo(hi.y) * e, bfhi(hi.y) * e);
                    *(GAS v4u*)(QD + ((size_t)item * 16 + f) * 512 + lane * 8) = o;
                } else {
                    const int f2 = f - 16, dblk = f2 >> 1, s = f2 & 1, d = 16 * dblk + li, c0 = 32 * s + 4 * lg, c1 = c0 + 16;
                    const u32x2v lo = *(const LAS u32x2v*)(L + CK_KT + d * 144 + c0 * 2), hi = *(const LAS u32x2v*)(L + CK_KT + d * 144 + c1 * 2);
                    const f32x4 e0 = *(const LAS f32x4*)(tab + 192 + c0), e1 = *(const LAS f32x4*)(tab + 192 + c1);
                    v4u o; o.x = pk2(bflo(lo.x) * e0[0], bfhi(lo.x) * e0[1]); o.y = pk2(bflo(lo.y) * e0[2], bfhi(lo.y) * e0[3]); o.z = pk2(bflo(hi.x) * e1[0], bfhi(hi.x) * e1[1]); o.w = pk2(bflo(hi.y) * e1[2], bfhi(hi.y) * e1[3]);
                    *(GAS v4u*)(KDT + ((size_t)item * 16 + f2) * 512 + lane * 8) = o;
                }
            }
        }
        LDS_BAR();
        asm volatile("" : "+v"(lane)); li = lane & 15; lg = lane >> 4;
        {
            s16x8 tb[4][2];
#pragma unroll
            for (int mb = 0; mb < 4; ++mb)
#pragma unroll
                for (int s = 0; s < 2; ++s) tb[mb][s] = *(const LAS s16x8*)(L + CK_TB + (16 * mb + li) * 144 + 64 * s + 16 * lg);
            s16x8 vb[2], kb[2];
#pragma unroll
            for (int s = 0; s < 2; ++s) { vb[s] = *(const LAS s16x8*)(L + CK_VBT + (16 * w + li) * 144 + 64 * s + 16 * lg); kb[s] = *(const LAS s16x8*)(L + CK_KBET + (16 * w + li) * 144 + 64 * s + 16 * lg); }
#pragma unroll
            for (int mb = 0; mb < 4; ++mb) {
                f32x4 u = (f32x4){0.f, 0.f, 0.f, 0.f}, wv = (f32x4){0.f, 0.f, 0.f, 0.f};
#pragma unroll
                for (int s = 0; s < 2; ++s) { u = mma16(tb[mb][s], vb[s], u); wv = mma16(kb[s], tb[mb][s], wv); }
                *(GAS f32x4*)(U + (((size_t)item * 8 + w) * 4 + mb) * 256 + lane * 4) = u;
                u32x2v o; o.x = pk2(-wv[0], -wv[1]); o.y = pk2(-wv[2], -wv[3]);
                *(GAS u32x2v*)(WN + ((size_t)item * 16 + mb * 4 + (w >> 1)) * 512 + lane * 8 + 4 * (w & 1)) = o;
            }
        }
        LDS_BAR();
    }
}
constexpr int SC_BUFB = 57344, SC_PART = 2 * SC_BUFB;
__device__ __forceinline__ void gdn_scan(Frame& F, int bh, const bf16* WN, const bf16* QD, const bf16* KDT, const bf16* QK, const float* U, const float* GL, const float* ng, bf16* P) {
    LAS unsigned char* L = F.lds;
    LAS float* part = (LAS float*)(L + SC_PART);
    const int w = F.wave, lane = F.lane, li = lane & 15, lg = lane >> 4;
    const int b = bh >> 2, h = bh & 3;
    f32x4 S[8];
#pragma unroll
    for (int k = 0; k < 8; ++k) S[k] = (f32x4){0.f, 0.f, 0.f, 0.f};
    f32x4 ucur[4], unext[4], oprev[4];
#pragma unroll
    for (int k = 0; k < 4; ++k) { unext[k] = (f32x4){0.f, 0.f, 0.f, 0.f}; oprev[k] = (f32x4){0.f, 0.f, 0.f, 0.f}; }
#define SC_ISSUE(nn) do { const size_t ch_ = (size_t)bh * 32 + (nn); const int bo_ = ((nn) & 1) * SC_BUFB; \
        _Pragma("unroll") for (int k_ = 0; k_ < 7; ++k_) { const int p_ = w * 7 + k_; \
            const bf16* src_ = (p_ < 16) ? WN + (ch_ * 16 + p_) * 512 : (p_ < 32) ? QD + (ch_ * 16 + (p_ - 16)) * 512 : (p_ < 48) ? KDT + (ch_ * 16 + (p_ - 32)) * 512 : QK + (ch_ * 8 + (p_ - 48)) * 512; \
            __builtin_amdgcn_global_load_lds((const unsigned*)(src_ + lane * 8), (LAS unsigned*)(L + bo_ + p_ * 1024), 16, 0, 0); } \
        _Pragma("unroll") for (int mb_ = 0; mb_ < 4; ++mb_) unext[mb_] = *(const GAS f32x4*)(U + ((ch_ * 8 + w) * 4 + mb_) * 256 + lane * 4); } while (0)
#define SC_FINISH(nn) do { const LAS float* pp_ = part + ((nn) & 1) * 512; const float gcol_ = ng[16 * w + li]; const int col_ = h * 128 + 16 * w + li; \
        _Pragma("unroll") for (int mb_ = 0; mb_ < 4; ++mb_) _Pragma("unroll") for (int r_ = 0; r_ < 4; ++r_) { const int row_ = 16 * mb_ + 4 * lg + r_; \
            const f32x4 p0_ = *(const LAS f32x4*)(pp_ + row_ * 8), p1_ = *(const LAS f32x4*)(pp_ + row_ * 8 + 4); \
            const float tot_ = ((p0_[0] + p0_[1]) + (p0_[2] + p0_[3])) + ((p1_[0] + p1_[1]) + (p1_[2] + p1_[3])); \
            const float rs_ = rsqrtf(tot_ * (1.f / 128.f) + EPS); \
            bf16* pr_ = P + ((size_t)b * SEQ + (size_t)(nn) * 64 + row_) * PW; \
            const float z_ = bf2f(pr_[1536 + col_]); \
            pr_[col_] = (bf16)f2bf(oprev[mb_][r_] * rs_ * gcol_ * silu_f(z_)); } } while (0)
    SC_ISSUE(0);
    for (int n = 0; n < 32; ++n) {
        LDS_BAR();
#pragma unroll
        for (int k = 0; k < 4; ++k) ucur[k] = unext[k];
        if (n + 1 < 32) SC_ISSUE(n + 1);
        if (n > 0) SC_FINISH(n - 1);
        const LAS unsigned char* B = L + (n & 1) * SC_BUFB;
        s16x8 sb[4];
#pragma unroll
        for (int s = 0; s < 4; ++s) sb[s] = pack8f(S[2 * s], S[2 * s + 1]);
        f32x4 vn[4], o[4];
#pragma unroll
        for (int mb = 0; mb < 4; ++mb) { vn[mb] = ucur[mb]; o[mb] = (f32x4){0.f, 0.f, 0.f, 0.f}; }
#pragma unroll
        for (int mb = 0; mb < 4; ++mb)
#pragma unroll
            for (int s = 0; s < 4; ++s) {
                const s16x8 aw = *(const LAS s16x8*)(B + (mb * 4 + s) * 1024 + lane * 16);
                const s16x8 aq = *(const LAS s16x8*)(B + 16384 + (mb * 4 + s) * 1024 + lane * 16);
                vn[mb] = mma16(aw, sb[s], vn[mb]); o[mb] = mma16(aq, sb[s], o[mb]);
            }
        s16x8 vb[2];
#pragma unroll
        for (int s = 0; s < 2; ++s) vb[s] = pack8f(vn[2 * s], vn[2 * s + 1]);
#pragma unroll
        for (int mb = 0; mb < 4; ++mb)
#pragma unroll
            for (int s = 0; s < 2; ++s) { const s16x8 a = *(const LAS s16x8*)(B + 49152 + (mb * 2 + s) * 1024 + lane * 16); o[mb] = mma16(a, vb[s], o[mb]); }
        const float gl = GL[bh * 32 + n];
#pragma unroll
        for (int db = 0; db < 8; ++db) {
            S[db] = S[db] * gl;
#pragma unroll
            for (int s = 0; s < 2; ++s) { const s16x8 a = *(const LAS s16x8*)(B + 32768 + (db * 2 + s) * 1024 + lane * 16); S[db] = mma16(a, vb[s], S[db]); }
        }
        LAS float* pw = part + (n & 1) * 512;
#pragma unroll
        for (int mb = 0; mb < 4; ++mb)
#pragma unroll
            for (int r = 0; r < 4; ++r) { float p = o[mb][r] * o[mb][r]; p += __shfl_xor(p, 1); p += __shfl_xor(p, 2); p += __shfl_xor(p, 4); p += __shfl_xor(p, 8);
                if (li == 0) pw[(16 * mb + 4 * lg + r) * 8 + w] = p; }
#pragma unroll
        for (int k = 0; k < 4; ++k) oprev[k] = o[k];
    }
    LDS_BAR();
    SC_FINISH(31);
    LDS_BAR();
#undef SC_ISSUE
#undef SC_FINISH
}

struct Args { const float* in[27]; float* out; unsigned char* ws; };
__global__ void __launch_bounds__(NTHREADS, 2) mk_fwd(Args args) {
    extern __shared__ __attribute__((aligned(16))) unsigned char lds[];
    Frame F;
    F.lds = (LAS unsigned char*)lds;
    F.MISC = (volatile LAS unsigned*)(F.lds + MISC_OFF);
    F.tid = threadIdx.x; F.lane = F.tid & 63; F.wave = __builtin_amdgcn_readfirstlane(F.tid >> 6);
    F.G = gridDim.x; { const int bx = blockIdx.x; F.vcu = (F.G % 8 == 0) ? (bx % 8) * (F.G / 8) + bx / 8 : bx; }
    unsigned char* ws = args.ws;
    F.ctl = (gu32*)(ws + WS_CTL);
    for (int u = F.tid; u < (LDS_BYTES - LDSCTL_OFF) / 4; u += NTHREADS) ((LAS unsigned*)(F.lds + LDSCTL_OFF))[u] = 0u;
    __syncthreads();
    XcdBarrier bar = xcd_barrier_post((unsigned*)(F.ctl + CW_BAR), F.MISC + 8);
#define GRID_BAR() do { xcd_barrier(bar); F.tid = threadIdx.x; asm volatile("" : "+v"(F.tid)); F.lane = F.tid & 63; } while (0)
    float* out = (float*)INP(27);
    bf16* XN = (bf16*)(ws + WS_XN); bf16* HB = (bf16*)(ws + WS_HB); bf16* PROJ = (bf16*)(ws + WS_PROJ); bf16* T1 = (bf16*)(ws + WS_T1); bf16* QB = (bf16*)(ws + WS_Q);
    bf16* KM = (bf16*)(ws + WS_KM); bf16* VM = (bf16*)(ws + WS_VM); float* AB = (float*)(ws + WS_AB);
    const int bid = (int)blockIdx.x;

    enum { K_PRO = 0, K_SWIGLU, K_GBF16, K_NORM, K_PROJ, K_CHUNK, K_SCAN, K_XATTN };
#pragma unroll 1
    for (int ph = 0; ph < 16; ++ph) {
        int kind = K_PRO; size_t wA = 0, wB = 0, wO = 0; int K = DM, lda = DM; int gx = 0, g1 = 0, g2 = -1; float sc = 1.f;
        switch (ph) {
            case 0:  kind = K_PRO; break;
            case 1:  kind = K_SWIGLU; wB = WS_W1GU; break;
            case 2:  kind = K_GBF16; wA = WS_HB; wB = WS_W1D; wO = WS_T1; K = DFF; lda = DFF; break;
            case 3:  kind = K_NORM; gx = 0; g1 = 6; g2 = 7; sc = 0.5f; break;
            case 4:  kind = K_PROJ; break;
            case 5:  kind = K_CHUNK; break;
            case 6:  kind = K_SCAN; break;
            case 7:  kind = K_GBF16; wA = WS_PROJ; wB = WS_WOUT; wO = WS_T1; K = DM; lda = PW; break;
            case 8:  kind = K_NORM; gx = 27; g1 = 14; g2 = 15; break;
            case 9:  kind = K_GBF16; wA = WS_XN; wB = WS_WQ; wO = WS_Q; break;
            case 10: kind = K_XATTN; break;
            case 11: kind = K_GBF16; wA = WS_XN; wB = WS_WO; wO = WS_T1; break;
            case 12: kind = K_NORM; gx = 27; g1 = 21; g2 = 22; break;
            case 13: kind = K_SWIGLU; wB = WS_W2GU; break;
            case 14: kind = K_GBF16; wA = WS_HB; wB = WS_W2D; wO = WS_T1; K = DFF; lda = DFF; break;
            default: kind = K_NORM; gx = 27; g1 = 26; g2 = -1; sc = 0.5f; break;
        }
        if (kind == K_PRO) p0_prologue(F, ws);
        else if (kind == K_SWIGLU) { pg8::Gemm g{XN, (const bf16*)(ws + wB), MTOK, 2 * DFF, DM, DM}; pg8::StaticOrder S; S.init(MTOK, 2 * DFF, F.G, bid); pg8::EpiSwiglu E{HB, DFF};
            pg8::gemm_phase<pg8::EpiSwiglu, pg8::StaticOrder, true, true>(F.lds + RING_OFF, g, S, E); }
        else if (kind == K_GBF16) { pg8::Gemm g{(const bf16*)(ws + wA), (const bf16*)(ws + wB), MTOK, DM, K, lda}; pg8::StaticOrder S; S.init(MTOK, DM, F.G, bid); pg8::EpiBf16 E{(bf16*)(ws + wO), DM};
            pg8::gemm_phase<pg8::EpiBf16, pg8::StaticOrder, true, true>(F.lds + RING_OFF, g, S, E); }
        else if (kind == K_NORM) norm_pass(F, INP(gx), T1, INP(g1), sc, out, g2 >= 0 ? INP(g2) : nullptr, XN);
        else if (kind == K_PROJ) { pg8::Gemm g{XN, (const bf16*)(ws + WS_WIN), MTOK + MMEM, 3840 + 2048, DM, DM}; pg8::ProjKvOrder S; S.init(F.G, bid); pg8::EpiProjKv E{PROJ, AB, KM, VM};
            pg8::gemm_phase<pg8::EpiProjKv, pg8::ProjKvOrder, true, true>(F.lds + RING_OFF, g, S, E); }
        else if (kind == K_CHUNK) gdn_chunk(F, PROJ, AB, INP(9), INP(10), INP(11), (bf16*)(ws + WS_CWN), (bf16*)(ws + WS_CQD), (bf16*)(ws + WS_CKDT), (bf16*)(ws + WS_CQK), (float*)(ws + WS_CU), (float*)(ws + WS_GL));
        else if (kind == K_SCAN) { if (bid < 32) gdn_scan(F, bid, (const bf16*)(ws + WS_CWN), (const bf16*)(ws + WS_CQD), (const bf16*)(ws + WS_CKDT), (const bf16*)(ws + WS_CQK), (const float*)(ws + WS_CU), (const float*)(ws + WS_GL), INP(12), PROJ);
                                   else swa_naive(F, PROJ, bid - 32, F.G - 32); }
        else xattn_naive(F, QB, KM, VM, XN);
        if (ph < 15) GRID_BAR();
    }
#undef GRID_BAR
}

extern "C" void kernel_launch(void* const* d_in, const int* in_sizes, int n_in, void* d_out, int out_size, void* d_ws, size_t ws_size, hipStream_t stream) {
    static int grid = 0;
    if (grid == 0) {
        if (n_in != 27 || out_size != MTOK * DM || ws_size < WS_END) { fprintf(stderr, "kernel_launch: unexpected shapes (n_in %d, out %d, ws %zu)\n", n_in, out_size, ws_size); grid = -1; return; }
        int dev = 0, cus = 0, per_cu = 0;
        if (hipGetDevice(&dev) != hipSuccess || hipDeviceGetAttribute(&cus, hipDeviceAttributeMultiprocessorCount, dev) != hipSuccess) { grid = -1; return; }
        if (hipFuncSetAttribute((const void*)mk_fwd, hipFuncAttributeMaxDynamicSharedMemorySize, LDS_BYTES) != hipSuccess) { fprintf(stderr, "kernel_launch: hipFuncSetAttribute failed\n"); grid = -1; return; }
        if (hipOccupancyMaxActiveBlocksPerMultiprocessor(&per_cu, (const void*)mk_fwd, NTHREADS, LDS_BYTES) != hipSuccess || per_cu < 1) fprintf(stderr, "kernel_launch: occupancy query reports %d\n", per_cu);
        (void)hipGetLastError();
        grid = cus;
    }
    if (grid < 0) return;
    if (hipMemsetAsync((char*)d_ws + WS_CTL, 0, CTL_ZERO_BYTES, stream) != hipSuccess) return;
    Args a{};
    for (int i = 0; i < 27; ++i) a.in[i] = (const float*)d_in[i];
    a.out = (float*)d_out; a.ws = (unsigned char*)d_ws;
    hipLaunchKernelGGL(mk_fwd, dim3(grid), dim3(NTHREADS), LDS_BYTES, stream, a);
}
```

```cpp
#include <hip/hip_runtime.h>
#include <cstdio>
#include <cstdint>
#include <cmath>
namespace pg8 {
#define PG8_LAS __attribute__((address_space(3)))
typedef unsigned short bf16_t;
typedef short bf16x8 __attribute__((ext_vector_type(8)));
typedef float f32x4 __attribute__((ext_vector_type(4)));
typedef unsigned u32x4 __attribute__((ext_vector_type(4)));
constexpr int BM = 256, BK = 64, HALF = 128, HTB = HALF * BK * 2  , STAGE_BYTES = 8 * HTB, NXCD = 8, WGM = 8;
__host__ __device__ __forceinline__ int lds_byte(int r, int c) { const int st = (r >> 4) * 2 + (c >> 5), rr = r & 15, cc = c & 31, ob = rr * 64 + cc * 2; return st * 1024 + (ob ^ (((ob >> 9) & 1) << 5)); }
__host__ __device__ __forceinline__ void stage_rc(int b, int& R, int& C) { const int st = b / 1024, sb = b % 1024, swz = sb ^ (((sb >> 9) & 1) << 5); R = (st >> 1) * 16 + swz / 64; C = (st & 1) * 32 + (swz % 64) / 2; }
__host__ __device__ __forceinline__ int perm32(int rho) { const int n = rho >> 4, i = rho & 15; return 8 * (i >> 2) + 4 * n + (i & 3); }
struct Unit { int pm, pn; };
struct Gemm { const bf16_t* A; const bf16_t* Bt; int M, N, K, lda; };

struct StaticOrder {
    int nM, nN, nwg, G, c;
    __host__ __device__ void init(int M, int N, int G_, int c_) { nM = M / BM; nN = N / BM; nwg = nM * nN; G = G_; c = c_; }
    __host__ __device__ bool next(int i, Unit& u) const {
        const long L = (long)i * G + c; if (L >= nwg) return false;
        int wgid = (int)L; { const int q = nwg / NXCD, r = nwg % NXCD, xcd = wgid % NXCD, off = wgid / NXCD; wgid = (xcd < r ? xcd * (q + 1) : r * (q + 1) + (xcd - r) * q) + off; }
        const int nig = WGM * nN, gid = wgid / nig, fm = gid * WGM, gsz = (nM - fm) < WGM ? (nM - fm) : WGM;
        u.pm = fm + ((wgid % nig) % gsz); u.pn = (wgid % nig) / gsz; return true;
    }
    __device__ __forceinline__ void a_ready(const Unit&) const {}
    __device__ __forceinline__ void done(const Unit&) const {}
};
struct ProjKvOrder {
    StaticOrder so; int G, c;
    __host__ __device__ void init(int G_, int c_) { so.init(16384, 3840, G_, c_); G = G_; c = c_; }
    __host__ __device__ bool next(int i, Unit& u) const {
        if (so.next(i, u)) return true;
        const long kv = (long)i * G + c - so.nwg; if (kv < 0 || kv >= 64) return false;
        u.pm = 64 + (int)(kv & 7); u.pn = 15 + (int)(kv >> 3); return true;
    }
    __device__ __forceinline__ void a_ready(const Unit&) const {}
    __device__ __forceinline__ void done(const Unit&) const {}
};

__device__ __forceinline__ unsigned cvt_pk_bf16(float lo, float hi) { unsigned r; asm volatile("v_cvt_pk_bf16_f32 %0, %1, %2" : "=v"(r) : "v"(lo), "v"(hi)); return r; }
__device__ __forceinline__ float fast_silu(float x) { return x * __builtin_amdgcn_rcpf(1.0f + __builtin_amdgcn_exp2f(-1.4426950408889634f * x)); }
__device__ __forceinline__ u32x4 pack8(const f32x4 a, const f32x4 b) { u32x4 w; w.x = cvt_pk_bf16(a[0], a[1]); w.y = cvt_pk_bf16(a[2], a[3]); w.z = cvt_pk_bf16(b[0], b[1]); w.w = cvt_pk_bf16(b[2], b[3]); return w; }

struct EpiBf16 {
    static constexpr bool PERM = true, AFTER_DRAIN = false;
    bf16_t* O; int ldc;
    __device__ __forceinline__ void operator()(const f32x4 (&acc)[2][2][4][2], const Unit& u, int wr, int wc, int fr, int fq) const {
        const int row0 = u.pm * BM + wr * 64 + fr, col0 = u.pn * BM + wc * 32 + 8 * fq;
#pragma unroll
        for (int ai = 0; ai < 2; ++ai)
#pragma unroll
            for (int m = 0; m < 4; ++m) { bf16_t* rowp = O + (size_t)(row0 + ai * HALF + m * 16) * ldc + col0;
#pragma unroll
                for (int bj = 0; bj < 2; ++bj) *(u32x4*)(rowp + bj * HALF) = pack8(acc[ai][bj][m][0], acc[ai][bj][m][1]); }
    }
};
struct EpiSwiglu {
    static constexpr bool PERM = true, AFTER_DRAIN = false;
    bf16_t* O; int ldc;
    __device__ __forceinline__ void operator()(const f32x4 (&acc)[2][2][4][2], const Unit& u, int wr, int wc, int fr, int fq) const {
        const int row0 = u.pm * BM + wr * 64 + fr, col0 = u.pn * HALF + wc * 32 + 8 * fq;
#pragma unroll
        for (int ai = 0; ai < 2; ++ai)
#pragma unroll
            for (int m = 0; m < 4; ++m) { bf16_t* rowp = O + (size_t)(row0 + ai * HALF + m * 16) * ldc + col0;
                f32x4 h0, h1;
#pragma unroll
                for (int e = 0; e < 4; ++e) { h0[e] = fast_silu(acc[ai][0][m][0][e]) * acc[ai][1][m][0][e]; h1[e] = fast_silu(acc[ai][0][m][1][e]) * acc[ai][1][m][1][e]; }
                *(u32x4*)rowp = pack8(h0, h1); }
    }
};
struct EpiProjKv {
    static constexpr bool PERM = true, AFTER_DRAIN = false;
    bf16_t* P; float* AB; bf16_t* KM; bf16_t* VM;
    __device__ __forceinline__ void operator()(const f32x4 (&acc)[2][2][4][2], const Unit& u, int wr, int wc, int fr, int fq) const {
        if (u.pn < 14) {
            const int row0 = u.pm * BM + wr * 64 + fr, col0 = u.pn * BM + wc * 32 + 8 * fq;
#pragma unroll
            for (int ai = 0; ai < 2; ++ai)
#pragma unroll
                for (int m = 0; m < 4; ++m) { bf16_t* rowp = P + (size_t)(row0 + ai * HALF + m * 16) * 3584 + col0;
#pragma unroll
                    for (int bj = 0; bj < 2; ++bj) *(u32x4*)(rowp + bj * HALF) = pack8(acc[ai][bj][m][0], acc[ai][bj][m][1]); }
        } else if (u.pn == 14) {
            if (wc == 0 && fq == 0) {
                const int row0 = u.pm * BM + wr * 64 + fr;
#pragma unroll
                for (int ai = 0; ai < 2; ++ai)
#pragma unroll
                    for (int m = 0; m < 4; ++m) { float* rowp = AB + (size_t)(row0 + ai * HALF + m * 16) * 8; *(f32x4*)rowp = acc[ai][0][m][0]; *(f32x4*)(rowp + 4) = acc[ai][0][m][1]; }
            }
        } else {
            const int row0 = (u.pm - 64) * BM + wr * 64 + fr; int ct = (u.pn - 15) * BM; bf16_t* base = KM; if (ct >= 1024) { ct -= 1024; base = VM; }
            const int col0 = ct + wc * 32 + 8 * fq;
#pragma unroll
            for (int ai = 0; ai < 2; ++ai)
#pragma unroll
                for (int m = 0; m < 4; ++m) { bf16_t* rowp = base + (size_t)(row0 + ai * HALF + m * 16) * 1024 + col0;
#pragma unroll
                    for (int bj = 0; bj < 2; ++bj) *(u32x4*)(rowp + bj * HALF) = pack8(acc[ai][bj][m][0], acc[ai][bj][m][1]); }
        }
    }
};

template <class Epi, class Sched, bool ALIGN_EPI = false, bool SP2 = false>
__device__ __forceinline__ void gemm_phase(PG8_LAS unsigned char* lds, const Gemm g, const Sched& S, const Epi& E) {
    int tid_ = threadIdx.x; asm volatile("" : "+v"(tid_));
    const int tid = tid_, wid = __builtin_amdgcn_readfirstlane(tid >> 6), lane = tid & 63, wr = wid >> 2, wc = wid & 3, fr = lane & 15, fq = lane >> 4;
    const int K = g.K, nt = K / BK;
    unsigned voffA[2], voffB[2];
#pragma unroll
    for (int i = 0; i < 2; ++i) { int R, C; stage_rc(tid * 16 + i * 8192, R, C); const int Rb = Epi::PERM ? ((R & ~31) + perm32(R & 31)) : R;
        voffA[i] = (unsigned)(R * g.lda + C) * 2u; voffB[i] = (unsigned)(Rb * K + C) * 2u; }
    const size_t kstep = (size_t)(BK * 2);
    const size_t hstepA = (size_t)HALF * g.lda * 2, hstepB = (size_t)HALF * K * 2;
    const size_t tstepA = 2 * hstepA, tstepB = 2 * hstepB;
    const unsigned ldsw = (unsigned)wid * 1024u;
    const int aoff = lds_byte(wr * 64 + fr, fq * 8), boff = lds_byte(wc * 32 + fr, fq * 8);
#define PG8_SA(b, h) (((b) * 2 + (h)) * HTB)
#define PG8_SB(b, h) ((4 + (b) * 2 + (h)) * HTB)
#define PG8_STAGE(bufoff, gbase, voff) do { _Pragma("unroll") for (int _i = 0; _i < 2; ++_i) \
        __builtin_amdgcn_global_load_lds((const unsigned*)((const char*)(gbase) + (voff)[_i]), (PG8_LAS unsigned*)(lds + (bufoff) + ldsw + _i * 8192), 16, 0, 0); } while (0)
#define PG8_LDA(dst, b, h) do { _Pragma("unroll") for (int m = 0; m < 4; ++m) _Pragma("unroll") for (int k = 0; k < 2; ++k) dst[m][k] = *(const PG8_LAS bf16x8*)(lds + PG8_SA(b, h) + aoff + m * 2048 + k * 1024); } while (0)
#define PG8_LDB(dst, b, h) do { _Pragma("unroll") for (int n = 0; n < 2; ++n) _Pragma("unroll") for (int k = 0; k < 2; ++k) dst[n][k] = *(const PG8_LAS bf16x8*)(lds + PG8_SB(b, h) + boff + n * 2048 + k * 1024); } while (0)
#define PG8_MMA(ai, bj, At, Bt) do { __builtin_amdgcn_s_setprio(1); _Pragma("unroll") for (int m = 0; m < 4; ++m) _Pragma("unroll") for (int n = 0; n < 2; ++n) _Pragma("unroll") for (int k = 0; k < 2; ++k) \
        acc[ai][bj][m][n] = __builtin_amdgcn_mfma_f32_16x16x32_bf16(Bt[n][k], At[m][k], acc[ai][bj][m][n], 0, 0, 0); __builtin_amdgcn_s_setprio(0); } while (0)
#define PG8_WAIT_V(n) asm volatile("s_waitcnt vmcnt(" #n ")" ::: "memory")
#define PG8_WAIT_L(n) asm volatile("s_waitcnt lgkmcnt(" #n ")" ::: "memory")
#define PG8_BAR __builtin_amdgcn_s_barrier()
#define PG8_SCHED __builtin_amdgcn_sched_barrier(0)
    Unit cur, nxt; int ui = 0;
    if (!S.next(0, cur)) return;
    f32x4 acc[2][2][4][2];
#pragma unroll
    for (int a = 0; a < 2; ++a)
#pragma unroll
        for (int b = 0; b < 2; ++b)
#pragma unroll
            for (int m = 0; m < 4; ++m)
#pragma unroll
                for (int n = 0; n < 2; ++n) acc[a][b][m][n] = (f32x4){0.f, 0.f, 0.f, 0.f};
    bf16x8 At[4][2], B0[2][2], B1[2][2];
    const char* cA = (const char*)g.A + (size_t)cur.pm * tstepA; const char* cB = (const char*)g.Bt + (size_t)cur.pn * tstepB;
    S.a_ready(cur);
    if constexpr (SP2) {
        PG8_STAGE(PG8_SB(0, 0), cB, voffB); PG8_STAGE(PG8_SB(0, 1), cB + hstepB, voffB); PG8_STAGE(PG8_SA(0, 0), cA, voffA); PG8_STAGE(PG8_SA(0, 1), cA + hstepA, voffA);
        if (wr == 1) PG8_BAR;
        PG8_WAIT_V(2); PG8_BAR;
        PG8_STAGE(PG8_SB(1, 0), cB + kstep, voffB); PG8_STAGE(PG8_SA(1, 0), cA + kstep, voffA); PG8_STAGE(PG8_SB(1, 1), cB + hstepB + kstep, voffB);
        PG8_WAIT_V(6); PG8_BAR;
    } else {
        PG8_STAGE(PG8_SB(0, 0), cB, voffB); PG8_STAGE(PG8_SA(0, 0), cA, voffA); PG8_STAGE(PG8_SB(0, 1), cB + hstepB, voffB); PG8_STAGE(PG8_SA(0, 1), cA + hstepA, voffA);
        if (wr == 1) PG8_BAR;
        PG8_WAIT_V(4); PG8_BAR;
        PG8_STAGE(PG8_SB(1, 0), cB + kstep, voffB); PG8_STAGE(PG8_SA(1, 0), cA + kstep, voffA); PG8_STAGE(PG8_SB(1, 1), cB + hstepB + kstep, voffB);
        PG8_WAIT_V(6); PG8_BAR;
    }
    for (;;) {
        const bool has_next = S.next(ui + 1, nxt);
        const char* nA = has_next ? (const char*)g.A + (size_t)nxt.pm * tstepA : cA; const char* nB = has_next ? (const char*)g.Bt + (size_t)nxt.pn * tstepB : cB;
        for (int t = 0; t < nt; t += 2) {
            const bool last = (t == nt - 2);
            const char* a1 = cA + (size_t)(t + 1) * kstep;
            const char* a2 = last ? nA : cA + (size_t)(t + 2) * kstep; const char* b2 = last ? nB : cB + (size_t)(t + 2) * kstep;
            const char* a3 = a2 + kstep; const char* b3 = b2 + kstep;
            if (last && has_next) S.a_ready(nxt);
            if constexpr (SP2) {
            PG8_LDB(B0, 0, 0); PG8_LDB(B1, 0, 1); PG8_SCHED; PG8_LDA(At, 0, 0); PG8_STAGE(PG8_SA(1, 1), a1 + hstepA, voffA);
            PG8_WAIT_V(8); PG8_WAIT_L(0); PG8_BAR; PG8_MMA(0, 0, At, B0); PG8_MMA(0, 1, At, B1); PG8_BAR; PG8_SCHED;
            PG8_LDA(At, 0, 1); PG8_STAGE(PG8_SB(0, 0), b2, voffB); PG8_STAGE(PG8_SB(0, 1), b2 + hstepB, voffB); PG8_STAGE(PG8_SA(0, 0), a2, voffA);
            PG8_WAIT_V(8); PG8_WAIT_L(0); PG8_BAR; PG8_MMA(1, 0, At, B0); PG8_MMA(1, 1, At, B1); PG8_BAR; PG8_SCHED;
            PG8_LDB(B0, 1, 0); PG8_LDB(B1, 1, 1); PG8_SCHED; PG8_LDA(At, 1, 0); PG8_STAGE(PG8_SA(0, 1), a2 + hstepA, voffA);
            PG8_WAIT_V(8); PG8_WAIT_L(0); PG8_BAR; PG8_MMA(0, 0, At, B0); PG8_MMA(0, 1, At, B1); PG8_BAR; PG8_SCHED;
            PG8_LDA(At, 1, 1); PG8_STAGE(PG8_SB(1, 0), b3, voffB); PG8_STAGE(PG8_SB(1, 1), b3 + hstepB, voffB); PG8_STAGE(PG8_SA(1, 0), a3, voffA);
            PG8_WAIT_V(8); PG8_WAIT_L(0); PG8_BAR; PG8_MMA(1, 0, At, B0); PG8_MMA(1, 1, At, B1); PG8_BAR; PG8_SCHED;
            } else {
            PG8_LDB(B0, 0, 0); PG8_SCHED; PG8_LDA(At, 0, 0); PG8_STAGE(PG8_SA(1, 1), a1 + hstepA, voffA);
            PG8_WAIT_L(8); PG8_BAR; PG8_WAIT_L(0); PG8_MMA(0, 0, At, B0); PG8_BAR; PG8_SCHED;
            PG8_LDB(B1, 0, 1); PG8_STAGE(PG8_SB(0, 0), b2, voffB);
            PG8_BAR; PG8_WAIT_L(0); PG8_MMA(0, 1, At, B1); PG8_BAR;
            PG8_LDA(At, 0, 1); PG8_STAGE(PG8_SA(0, 0), a2, voffA);
            PG8_BAR; PG8_WAIT_L(0); PG8_MMA(1, 0, At, B0); PG8_BAR; PG8_SCHED;
            PG8_STAGE(PG8_SB(0, 1), b2 + hstepB, voffB);
            PG8_WAIT_V(6); PG8_BAR; PG8_MMA(1, 1, At, B1); PG8_BAR;
            PG8_LDB(B0, 1, 0); PG8_SCHED; PG8_LDA(At, 1, 0); PG8_STAGE(PG8_SA(0, 1), a2 + hstepA, voffA);
            PG8_WAIT_L(8); PG8_BAR; PG8_WAIT_L(0); PG8_MMA(0, 0, At, B0); PG8_BAR; PG8_SCHED;
            PG8_LDB(B1, 1, 1); PG8_STAGE(PG8_SB(1, 0), b3, voffB);
            PG8_BAR; PG8_WAIT_L(0); PG8_MMA(0, 1, At, B1); PG8_BAR;
            PG8_LDA(At, 1, 1); PG8_STAGE(PG8_SA(1, 0), a3, voffA);
            PG8_BAR; PG8_WAIT_L(0); PG8_MMA(1, 0, At, B0); PG8_BAR; PG8_SCHED;
            PG8_STAGE(PG8_SB(1, 1), b3 + hstepB, voffB);
            PG8_WAIT_V(6); PG8_BAR; PG8_MMA(1, 1, At, B1); PG8_BAR;
            }
        }
        if constexpr (ALIGN_EPI) { if (wr == 0) PG8_BAR; }
        if constexpr (!Epi::AFTER_DRAIN) { E(acc, cur, wr, wc, fr, fq); S.done(cur); }
        if (!has_next) break;
#pragma unroll
        for (int a = 0; a < 2; ++a)
#pragma unroll
            for (int b = 0; b < 2; ++b)
#pragma unroll
                for (int m = 0; m < 4; ++m)
#pragma unroll
                    for (int n = 0; n < 2; ++n) acc[a][b][m][n] = (f32x4){0.f, 0.f, 0.f, 0.f};
        cur = nxt; cA = nA; cB = nB; ++ui;
        if constexpr (ALIGN_EPI) { if (wr == 1) PG8_BAR; }
    }
    PG8_WAIT_V(0);
    if constexpr (!ALIGN_EPI) { if (wr == 0) PG8_BAR; }
    PG8_BAR;
    if constexpr (Epi::AFTER_DRAIN) { E.fused(acc, cur, wr, wc, fr, fq, lds, wid, lane); S.done(cur); }
#undef PG8_SA
#undef PG8_SB
#undef PG8_STAGE
#undef PG8_LDA
#undef PG8_LDB
#undef PG8_MMA
#undef PG8_WAIT_V
#undef PG8_WAIT_L
#undef PG8_BAR
#undef PG8_SCHED
}
}
#define GAS __attribute__((address_space(1)))
#define LAS __attribute__((address_space(3)))
typedef unsigned short bf16;
typedef unsigned v4u __attribute__((ext_vector_type(4)));
typedef float f32x4 __attribute__((ext_vector_type(4)));
typedef short bf16x8 __attribute__((ext_vector_type(8)));
typedef GAS unsigned gu32;
typedef GAS unsigned long long gu64;
#define RLX_AGENT __ATOMIC_RELAXED, __HIP_MEMORY_SCOPE_AGENT
#define LDS_WAIT() asm volatile("s_waitcnt lgkmcnt(0)" ::: "memory")
#define VM_WAIT() asm volatile("s_waitcnt vmcnt(0)" ::: "memory")
__device__ __forceinline__ unsigned long long rt() { return __builtin_amdgcn_s_memrealtime(); }
__device__ __forceinline__ unsigned f2bf(float f) { unsigned u = __builtin_bit_cast(unsigned, f); return (u + 0x7fffu + ((u >> 16) & 1u)) >> 16; }
__device__ __forceinline__ unsigned pk2(float lo, float hi) { return f2bf(lo) | (f2bf(hi) << 16); }

#define XB_TMO      128
#define XB_XCNT(j)  (256  + 64 * (j))
#define XB_XSUB(j)  (1280 + 64 * (j))
#define XB_XGEN(j)  (2304 + 64 * (j))
#define XB_TOP      3328
#define XB_TOPGEN   3392
#define XCD_BAR_WORDS 3456
#define XB_SPIN_CAP (1u << 18)

__device__ __forceinline__ unsigned xb_ld(unsigned* p)              { return __hip_atomic_load(p, __ATOMIC_RELAXED, __HIP_MEMORY_SCOPE_AGENT); }
__device__ __forceinline__ unsigned xb_add(unsigned* p, unsigned v) { return __hip_atomic_fetch_add(p, v, __ATOMIC_RELAXED, __HIP_MEMORY_SCOPE_AGENT); }
__device__ __forceinline__ unsigned xb_xcc_id() { return (unsigned)__builtin_amdgcn_s_getreg((3 << 11) | 20) & 0xFu; }
#define XB_SPIN(cond, bar) do { unsigned _sp = 0; while (cond) { __builtin_amdgcn_s_sleep(1); \
    if ((++_sp & 255u) == 0u) { if (xb_ld(&(bar)[XB_TMO])) break; if (_sp > XB_SPIN_CAP) { atomicAdd(&(bar)[XB_TMO], 1u); break; } } } } while (0)

struct XcdBarrier {
    unsigned* bar; unsigned x;
    volatile LAS unsigned* st;
};

__device__ __forceinline__ XcdBarrier xcd_barrier_post(unsigned* bar, volatile LAS unsigned* st) {
    XcdBarrier b; b.bar = bar; b.x = xb_xcc_id(); b.st = st;
    if (threadIdx.x == 0) (void)xb_add(&bar[XB_XCNT(b.x)], 1u);
    return b;
}
__device__ __forceinline__ void xcd_barrier_complete(unsigned* bar, unsigned x, unsigned& nloc, unsigned& nx) {
    const unsigned G = gridDim.x * gridDim.y * gridDim.z;
    unsigned sum, cnt, mine, sp = 0u;
    for (;;) {
        sum = 0u; cnt = 0u; mine = 0u;
#pragma unroll
        for (unsigned j = 0; j < 16; ++j) { const unsigned c = xb_ld(&bar[XB_XCNT(j)]); sum += c; cnt += (c > 0u) ? 1u : 0u; mine = (j == x) ? c : mine; }
        if (sum == G) break;
        __builtin_amdgcn_s_sleep(1);
        if ((++sp & 255u) == 0u) { if (xb_ld(&bar[XB_TMO])) break; if (sp > XB_SPIN_CAP) { atomicAdd(&bar[XB_TMO], 1u); break; } }
    }
    nloc = mine > 0u ? mine : 1u; nx = cnt > 0u ? cnt : 1u;
}

__device__ __forceinline__ void xcd_barrier(const XcdBarrier& b) {
    asm volatile("s_waitcnt vmcnt(0)" ::: "memory");
    __syncthreads();
    if (threadIdx.x == 0) {
        unsigned* bar = b.bar;
        __builtin_amdgcn_s_waitcnt(0);
        unsigned nloc = b.st[0], nx = b.st[1];
        if (nloc == 0u) { xcd_barrier_complete(bar, b.x, nloc, nx); b.st[0] = nloc; b.st[1] = nx; }
        const unsigned old = xb_add(&bar[XB_XSUB(b.x)], 1u);
        const unsigned gen = old / nloc;
        if (old + 1u == (gen + 1u) * nloc) {
            __builtin_amdgcn_fence(__ATOMIC_RELEASE, "agent");
            asm volatile("s_waitcnt vmcnt(0)" ::: "memory");
            const unsigned og = xb_add(&bar[XB_TOP], 1u);
            const unsigned tg = og / nx;
            if (og + 1u == (tg + 1u) * nx) xb_add(&bar[XB_TOPGEN], 1u);
            else XB_SPIN(xb_ld(&bar[XB_TOPGEN]) == tg, bar);
            __builtin_amdgcn_fence(__ATOMIC_ACQUIRE, "agent");
            xb_add(&bar[XB_XGEN(b.x)], 1u);
            asm volatile("s_waitcnt vmcnt(0)" ::: "memory");
        } else {
            XB_SPIN(xb_ld(&bar[XB_XGEN(b.x)]) == gen, bar);
            __builtin_amdgcn_fence(__ATOMIC_ACQUIRE, "agent");
            asm volatile("s_waitcnt vmcnt(0)" ::: "memory");
        }
    }
    __syncthreads();
}

constexpr int NWAVES = 8, NTHREADS = 512;
constexpr int DM = 1024, NBATCH = 8, SEQ = 2048, MTOK = NBATCH * SEQ, NMEM = 256, MMEM = NBATCH * NMEM, DFF = 2816, INC = 3592;
constexpr int PW = 3584;
constexpr float EPS = 1e-6f;
constexpr size_t MiB = 1u << 20;
constexpr size_t WS_CTL = 0, CTL_ZERO_BYTES = 1 * MiB;
constexpr size_t WS_W1GU = 1 * MiB, WS_W1D = 12 * MiB, WS_WIN = 35 * MiB / 2, WS_WKV = 25 * MiB, WS_WOUT = 29 * MiB, WS_WQ = 31 * MiB, WS_WO = 33 * MiB, WS_W2GU = 35 * MiB, WS_W2D = 46 * MiB;
constexpr size_t WS_XN = 52 * MiB;
constexpr size_t WS_QN = 52 * MiB, WS_KN = 68 * MiB;
constexpr size_t WS_BIG = 88 * MiB;
constexpr size_t WS_HB = 88 * MiB;
constexpr size_t WS_PROJ = 88 * MiB;
constexpr size_t WS_Q = 88 * MiB;
constexpr size_t WS_T1 = 200 * MiB;
constexpr size_t WS_VV = 200 * MiB;
constexpr size_t WS_AB = 232 * MiB, WS_BETA = 233 * MiB, WS_GG = 234 * MiB;
constexpr size_t WS_CWN = 1 * MiB, WS_CQK = 17 * MiB, WS_CU = 52 * MiB, WS_CQD = 200 * MiB, WS_CKDT = 216 * MiB, WS_GL = 235 * MiB;
constexpr size_t WS_KM = 240 * MiB, WS_VM = 244 * MiB, WS_END = 248 * MiB;
static_assert(WS_WIN + (size_t)3840 * 1024 * 2 == WS_WKV, "Wkv rows must directly follow Win rows");
constexpr int CW_BAR = 4096;
constexpr int RING_OFF = 0, RING_BYTES = 131072, LDSCTL_OFF = RING_BYTES, MISC_OFF = LDSCTL_OFF + 320, LDS_BYTES = 147456;

struct Frame {
    LAS unsigned char* lds; volatile LAS unsigned* MISC; gu32* ctl;
    int tid, lane, wave, vcu, G;
};
__device__ __forceinline__ float wave_sum(float v) {
#pragma unroll
    for (int o = 1; o < 64; o <<= 1) v += __shfl_xor(v, o);
    return v;
}
__device__ __forceinline__ float wave_max(float v) {
#pragma unroll
    for (int o = 1; o < 64; o <<= 1) v = fmaxf(v, __shfl_xor(v, o));
    return v;
}
__device__ __forceinline__ float bf2f(unsigned short b) { return __uint_as_float((unsigned)b << 16); }
__device__ __forceinline__ float bflo(unsigned w) { return __uint_as_float(w << 16); }
__device__ __forceinline__ float bfhi(unsigned w) { return __uint_as_float(w & 0xffff0000u); }
__device__ __forceinline__ float silu_f(float x) { return x / (1.f + __expf(-x)); }

__device__ __forceinline__ void transpose_item(const float* W, int ldw, int K, int k0, int srcbase, int nvalid, bf16* WT, int dstrow0, LAS float* scr, int lane) {
    const int nl = lane & 31; const bool ok = nl < nvalid;
#pragma unroll 8
    for (int i = 0; i < 32; ++i) { const int kk = 2 * i + (lane >> 5); scr[kk * 33 + nl] = ok ? W[(size_t)(k0 + kk) * ldw + srcbase + nl] : 0.f; }
    LDS_WAIT(); asm volatile("" ::: "memory");
    const int c = lane & 7;
#pragma unroll
    for (int j = 0; j < 4; ++j) { const int n = (lane >> 3) + 8 * j; const LAS float* s = scr + (8 * c) * 33 + n;
        v4u o; o.x = pk2(s[0 * 33], s[1 * 33]); o.y = pk2(s[2 * 33], s[3 * 33]); o.z = pk2(s[4 * 33], s[5 * 33]); o.w = pk2(s[6 * 33], s[7 * 33]);
        *(GAS v4u*)(WT + (size_t)(dstrow0 + n) * K + k0 + 8 * c) = o; }
    LDS_WAIT(); asm volatile("" ::: "memory");
}
__device__ __forceinline__ void conv_gu(const float* wg, const float* wu, bf16* WT, LAS float* scr, int it, int lane) {
    const int which = it / 1408, r = it % 1408, kb = r / 88, nb = r % 88, n0 = nb * 32;
    transpose_item(which ? wu : wg, DFF, DM, kb * 64, n0, 32, WT, 256 * (n0 >> 7) + (which ? 128 : 0) + (n0 & 127), scr, lane);
}
__device__ __forceinline__ void conv_plain(const float* w, int K, int N, bf16* WT, int rowoff, LAS float* scr, int it, int lane) {
    const int nblk = N / 32, kb = it / nblk, nb = it % nblk;
    transpose_item(w, N, K, kb * 64, nb * 32, 32, WT, rowoff + nb * 32, scr, lane);
}
__device__ __forceinline__ void conv_win(const float* w, bf16* WT, LAS float* scr, int it, int lane) {
    const int kb = it / 120, db = it % 120, d0 = db * 32;
    int srcbase = d0, nvalid = 32;
    if (d0 >= 2048 && d0 < 3584) srcbase = d0 + 8; else if (d0 == 3584) { srcbase = 2048; nvalid = 8; } else if (d0 > 3584) { srcbase = 0; nvalid = 0; }
    transpose_item(w, INC, DM, kb * 64, srcbase, nvalid, WT, d0, scr, lane);
}
__device__ __forceinline__ void norm_row_bf16(const float* xrow, const float* g, bf16* orow, int lane) {
    const GAS f32x4* xr = (const GAS f32x4*)xrow + lane; const GAS f32x4* gr = (const GAS f32x4*)g + lane;
    f32x4 v[4]; float s = 0.f;
#pragma unroll
    for (int j = 0; j < 4; ++j) { v[j] = xr[64 * j]; s += (v[j].x * v[j].x + v[j].y * v[j].y) + (v[j].z * v[j].z + v[j].w * v[j].w); }
    const float r = rsqrtf(wave_sum(s) * (1.f / DM) + EPS);
    GAS unsigned long long* o8 = (GAS unsigned long long*)orow + lane;
#pragma unroll
    for (int j = 0; j < 4; ++j) { const f32x4 gg = gr[64 * j]; o8[64 * j] = (unsigned long long)pk2(v[j].x * r * gg.x, v[j].y * r * gg.y) | ((unsigned long long)pk2(v[j].z * r * gg.z, v[j].w * r * gg.w) << 32); }
}
__device__ __forceinline__ const float* inptr(int i) { const char* ka = (const char*)__builtin_amdgcn_kernarg_segment_ptr(); int off = i * 8; asm volatile("" : "+s"(off)); return *(const float* const*)(ka + off); }
#define INP(i) inptr(i)
__device__ __forceinline__ void p0_prologue(Frame& F, unsigned char* ws) {
    LAS float* scr = (LAS float*)(F.lds + RING_OFF + F.wave * 16384);
    const int gw = F.vcu * NWAVES + F.wave, NGW = F.G * NWAVES;
    constexpr int I_GU = 2 * 16 * 88, I_D = 44 * 32, I_IN = 16 * 120, I_SQ = 16 * 32;
    constexpr int NITEMS = 2 * I_GU + 2 * I_D + I_IN + 5 * I_SQ;
    for (int it = gw; it < NITEMS; it += NGW) {
        int r = it;
        if (r < I_GU) { conv_gu(INP(3), INP(4), (bf16*)(ws + WS_W1GU), scr, r, F.lane); continue; } r -= I_GU;
        if (r < I_D) { conv_plain(INP(5), DFF, DM, (bf16*)(ws + WS_W1D), 0, scr, r, F.lane); continue; } r -= I_D;
        if (r < I_IN) { conv_win(INP(8), (bf16*)(ws + WS_WIN), scr, r, F.lane); continue; } r -= I_IN;
        if (r < I_SQ) { conv_plain(INP(18), DM, DM, (bf16*)(ws + WS_WKV), 0, scr, r, F.lane); continue; } r -= I_SQ;
        if (r < I_SQ) { conv_plain(INP(19), DM, DM, (bf16*)(ws + WS_WKV), 1024, scr, r, F.lane); continue; } r -= I_SQ;
        if (r < I_SQ) { conv_plain(INP(13), DM, DM, (bf16*)(ws + WS_WOUT), 0, scr, r, F.lane); continue; } r -= I_SQ;
        if (r < I_SQ) { conv_plain(INP(17), DM, DM, (bf16*)(ws + WS_WQ), 0, scr, r, F.lane); continue; } r -= I_SQ;
        if (r < I_SQ) { conv_plain(INP(20), DM, DM, (bf16*)(ws + WS_WO), 0, scr, r, F.lane); continue; } r -= I_SQ;
        if (r < I_GU) { conv_gu(INP(23), INP(24), (bf16*)(ws + WS_W2GU), scr, r, F.lane); continue; } r -= I_GU;
        conv_plain(INP(25), DFF, DM, (bf16*)(ws + WS_W2D), 0, scr, r, F.lane);
    }
    bf16* XN = (bf16*)(ws + WS_XN);
    for (int m = gw; m < MTOK + MMEM; m += NGW) {
        if (m < MTOK) norm_row_bf16(INP(0) + (size_t)m * DM, INP(2), XN + (size_t)m * DM, F.lane);
        else norm_row_bf16(INP(1) + (size_t)(m - MTOK) * DM, INP(16), XN + (size_t)m * DM, F.lane);
    }
}
__device__ __forceinline__ void norm_pass(Frame& F, const float* xin, const bf16* f, const float* g1, float scale, float* xout, const float* g2, bf16* XN) {
    const int gw = F.vcu * NWAVES + F.wave, NGW = F.G * NWAVES;
    for (int m = gw; m < MTOK; m += NGW) {
        const GAS f32x4* xr = (const GAS f32x4*)(xin + (size_t)m * DM) + F.lane;
        const GAS unsigned long long* fr = (const GAS unsigned long long*)(f + (size_t)m * DM) + F.lane;
        const GAS f32x4* g1r = (const GAS f32x4*)g1 + F.lane;
        f32x4 fv[4]; float s = 0.f;
#pragma unroll
        for (int j = 0; j < 4; ++j) { const unsigned long long w = fr[64 * j]; const unsigned lo = (unsigned)w, hi = (unsigned)(w >> 32);
            fv[j] = (f32x4){bflo(lo), bfhi(lo), bflo(hi), bfhi(hi)}; s += (fv[j].x * fv[j].x + fv[j].y * fv[j].y) + (fv[j].z * fv[j].z + fv[j].w * fv[j].w); }
        const float r1 = rsqrtf(wave_sum(s) * (1.f / DM) + EPS) * scale;
        float s2 = 0.f;
        GAS f32x4* xo = (GAS f32x4*)(xout + (size_t)m * DM) + F.lane;
#pragma unroll
        for (int j = 0; j < 4; ++j) { const f32x4 xx = xr[64 * j]; const f32x4 gg = g1r[64 * j];
            fv[j] = xx + fv[j] * gg * r1; s2 += (fv[j].x * fv[j].x + fv[j].y * fv[j].y) + (fv[j].z * fv[j].z + fv[j].w * fv[j].w); xo[64 * j] = fv[j]; }
        if (g2) {
            const float r2 = rsqrtf(wave_sum(s2) * (1.f / DM) + EPS);
            const GAS f32x4* g2r = (const GAS f32x4*)g2 + F.lane;
            GAS unsigned long long* o8 = (GAS unsigned long long*)(XN + (size_t)m * DM) + F.lane;
#pragma unroll
            for (int j = 0; j < 4; ++j) { const f32x4 gg = g2r[64 * j]; o8[64 * j] = (unsigned long long)pk2(fv[j].x * r2 * gg.x, fv[j].y * r2 * gg.y) | ((unsigned long long)pk2(fv[j].z * r2 * gg.z, fv[j].w * r2 * gg.w) << 32); }
        }
    }
}
__device__ __forceinline__ void swa_naive(Frame& F, bf16* P, int wg, int nwg) {
    for (int idx = wg * NTHREADS + F.tid; idx < MTOK * 8; idx += nwg * NTHREADS) {
        const int t = idx & (SEQ - 1), h = (idx >> 11) & 7, b = idx >> 14;
        const float slope = exp2f(-(float)(h + 1));
        const bf16* base = P + (size_t)b * SEQ * PW;
        float q[64], o[64];
        { const v4u* qp = (const v4u*)(base + (size_t)t * PW + 2048 + h * 64);
#pragma unroll
          for (int i = 0; i < 8; ++i) { const v4u w = qp[i]; q[8 * i] = bflo(w.x); q[8 * i + 1] = bfhi(w.x); q[8 * i + 2] = bflo(w.y); q[8 * i + 3] = bfhi(w.y); q[8 * i + 4] = bflo(w.z); q[8 * i + 5] = bfhi(w.z); q[8 * i + 6] = bflo(w.w); q[8 * i + 7] = bfhi(w.w); } }
#pragma unroll
        for (int i = 0; i < 64; ++i) o[i] = 0.f;
        float m = -INFINITY, l = 0.f;
        for (int br = 0; br < 3; ++br) {
            const int dil = (br == 0) ? 1 : (br == 1 ? 4 : 16);
            for (int dl = 0; dl <= 128; ++dl) {
                const int tk = t - dl * dil;
                if (tk < 0) break;
                const v4u* kp = (const v4u*)(base + (size_t)tk * PW + 2560 + h * 64);
                float s = 0.f;
#pragma unroll
                for (int i = 0; i < 8; ++i) { const v4u w = kp[i];
                    s = fmaf(q[8 * i], bflo(w.x), s); s = fmaf(q[8 * i + 1], bfhi(w.x), s); s = fmaf(q[8 * i + 2], bflo(w.y), s); s = fmaf(q[8 * i + 3], bfhi(w.y), s);
                    s = fmaf(q[8 * i + 4], bflo(w.z), s); s = fmaf(q[8 * i + 5], bfhi(w.z), s); s = fmaf(q[8 * i + 6], bflo(w.w), s); s = fmaf(q[8 * i + 7], bfhi(w.w), s); }
                s = s * 0.125f - slope * (float)(dil * dl);
                const float mn = fmaxf(m, s);
                const float c = __expf(m - mn), p = __expf(s - mn);
                l = l * c + p; m = mn;
                const v4u* vp = (const v4u*)(base + (size_t)tk * PW + 3072 + h * 64);
#pragma unroll
                for (int i = 0; i < 8; ++i) { const v4u w = vp[i];
                    o[8 * i] = o[8 * i] * c + p * bflo(w.x); o[8 * i + 1] = o[8 * i + 1] * c + p * bfhi(w.x); o[8 * i + 2] = o[8 * i + 2] * c + p * bflo(w.y); o[8 * i + 3] = o[8 * i + 3] * c + p * bfhi(w.y);
                    o[8 * i + 4] = o[8 * i + 4] * c + p * bflo(w.z); o[8 * i + 5] = o[8 * i + 5] * c + p * bfhi(w.z); o[8 * i + 6] = o[8 * i + 6] * c + p * bflo(w.w); o[8 * i + 7] = o[8 * i + 7] * c + p * bfhi(w.w); }
            }
        }
        const float il = 1.f / l;
        v4u* op = (v4u*)(P + ((size_t)b * SEQ + t) * PW + 512 + h * 64);
#pragma unroll
        for (int i = 0; i < 8; ++i) { v4u w; w.x = pk2(o[8 * i] * il, o[8 * i + 1] * il); w.y = pk2(o[8 * i + 2] * il, o[8 * i + 3] * il); w.z = pk2(o[8 * i + 4] * il, o[8 * i + 5] * il); w.w = pk2(o[8 * i + 6] * il, o[8 * i + 7] * il); op[i] = w; }
    }
}
__device__ __forceinline__ void xattn_naive(Frame& F, const bf16* Q, const bf16* KM, const bf16* VM, bf16* O) {
    LAS float* qs = (LAS float*)F.lds;
    LAS float* ps = qs + 2048;
    const int tid = F.tid, w = F.wave, lane = F.lane, rr = w >> 2, hd = w & 3;
    for (int rp = F.vcu; rp < MTOK / 2; rp += F.G) {
        const size_t row0 = (size_t)rp * 2;
        { const unsigned long long wq = *(const unsigned long long*)(Q + row0 * DM + tid * 4); const unsigned lo = (unsigned)wq, hi = (unsigned)(wq >> 32);
          qs[tid * 4] = bflo(lo); qs[tid * 4 + 1] = bfhi(lo); qs[tid * 4 + 2] = bflo(hi); qs[tid * 4 + 3] = bfhi(hi); }
        __syncthreads();
        const size_t row = row0 + rr; const int b = (int)(row >> 11);
        float sc[4];
#pragma unroll
        for (int i = 0; i < 4; ++i) {
            const int mk = lane + 64 * i;
            const v4u* kp = (const v4u*)(KM + ((size_t)b * NMEM + mk) * DM + hd * 256);
            const LAS float* qq = qs + rr * 1024 + hd * 256;
            float s = 0.f;
            for (int d8 = 0; d8 < 32; ++d8) { const v4u kw = kp[d8];
                s = fmaf(qq[8 * d8], bflo(kw.x), s); s = fmaf(qq[8 * d8 + 1], bfhi(kw.x), s); s = fmaf(qq[8 * d8 + 2], bflo(kw.y), s); s = fmaf(qq[8 * d8 + 3], bfhi(kw.y), s);
                s = fmaf(qq[8 * d8 + 4], bflo(kw.z), s); s = fmaf(qq[8 * d8 + 5], bfhi(kw.z), s); s = fmaf(qq[8 * d8 + 6], bflo(kw.w), s); s = fmaf(qq[8 * d8 + 7], bfhi(kw.w), s); }
            sc[i] = s * 0.0625f;
        }
        const float mx = wave_max(fmaxf(fmaxf(sc[0], sc[1]), fmaxf(sc[2], sc[3])));
        float e[4]; float sum = 0.f;
#pragma unroll
        for (int i = 0; i < 4; ++i) { e[i] = __expf(sc[i] - mx); sum += e[i]; }
        const float inv = 1.f / wave_sum(sum);
#pragma unroll
        for (int i = 0; i < 4; ++i) ps[w * 256 + lane + 64 * i] = e[i] * inv;
        __syncthreads();
        float a0 = 0.f, a1 = 0.f, a2 = 0.f, a3 = 0.f;
        for (int mk = 0; mk < NMEM; ++mk) {
            const float p = ps[w * 256 + mk];
            const unsigned long long vw = *(const unsigned long long*)(VM + ((size_t)b * NMEM + mk) * DM + hd * 256 + lane * 4); const unsigned lo = (unsigned)vw, hi = (unsigned)(vw >> 32);
            a0 = fmaf(p, bflo(lo), a0); a1 = fmaf(p, bfhi(lo), a1); a2 = fmaf(p, bflo(hi), a2); a3 = fmaf(p, bfhi(hi), a3);
        }
        *(unsigned long long*)(O + row * DM + hd * 256 + lane * 4) = (unsigned long long)pk2(a0, a1) | ((unsigned long long)pk2(a2, a3) << 32);
        __syncthreads();
    }
}

typedef short s16x8 __attribute__((ext_vector_type(8)));
typedef unsigned u32x2v __attribute__((ext_vector_type(2)));
__device__ __forceinline__ f32x4 mma16(s16x8 a, s16x8 b, f32x4 c) { return __builtin_amdgcn_mfma_f32_16x16x32_bf16(a, b, c, 0, 0, 0); }
__device__ __forceinline__ s16x8 pack8f(const f32x4 a, const f32x4 b) { v4u w; w.x = pk2(a[0], a[1]); w.y = pk2(a[2], a[3]); w.z = pk2(b[0], b[1]); w.w = pk2(b[2], b[3]); return __builtin_bit_cast(s16x8, w); }
#define LDS_BAR() do { asm volatile("s_waitcnt vmcnt(0) lgkmcnt(0)" ::: "memory"); __builtin_amdgcn_s_barrier(); asm volatile("" ::: "memory"); } while (0)
constexpr int CK_QB = 0, CK_KB = 17408, CK_KT = 34816, CK_VBT = 53248, CK_KBET = 71680, CK_AT = 90112, CK_TB = 107520, CK_TAB = 116736, CK_LR = 117760, CK_T0T = 120320;
__device__ __forceinline__ void gdn_chunk(Frame& F, const bf16* P, const float* AB, const float* convw, const float* a_log, const float* dt_bias,
                                          bf16* WN, bf16* QD, bf16* KDT, bf16* QK, float* U, float* GL) {
    LAS unsigned char* L = F.lds;
    LAS float* tab = (LAS float*)(L + CK_TAB);
    const int w = F.wave;
    for (int item = F.vcu; item < NBATCH * 4 * 32; item += F.G) {
        int lane = F.lane; asm volatile("" : "+v"(lane));
        int li = lane & 15, lg = lane >> 4;
        const int n = item & 31, bh = item >> 5, h = bh & 3, b = bh >> 2;
        const size_t row0 = (size_t)b * SEQ + (size_t)n * 64;
        if (w == 0) {
            const float a = AB[(row0 + lane) * 8 + h], bb = AB[(row0 + lane) * 8 + 4 + h];
            const float xx = a + dt_bias[h];
            const float ey = __expf(xx);
            const float sp = (xx > 20.f) ? xx : ((ey < 0.01f) ? ey * (1.f - ey * (0.5f - ey * 0.33333333f)) : __logf(1.f + ey));
            const float gt = -__expf(a_log[h]) * sp;
            float gc = gt;
#pragma unroll
            for (int o = 1; o < 64; o <<= 1) { const float tv = __shfl_up(gc, o); if (lane >= o) gc += tv; }
            const float gl = __shfl(gc, 63);
            tab[lane] = gc; tab[64 + lane] = 1.f / (1.f + __expf(-bb)); tab[128 + lane] = __expf(gc); tab[192 + lane] = __expf(gl - gc);
            if (lane == 63) GL[item] = __expf(gc);
        }
        LDS_BAR();
        {
            float cq[4][2], ck[4][2], cv[4][2];
#pragma unroll
            for (int j = 0; j < 4; ++j)
#pragma unroll
                for (int e = 0; e < 2; ++e) { const int c = h * 128 + lane + 64 * e; cq[j][e] = convw[j * 1536 + c]; ck[j][e] = convw[j * 1536 + 512 + c]; cv[j][e] = convw[j * 1536 + 1024 + c]; }
#pragma unroll 1
            for (int tt = 0; tt < 8; ++tt) {
                const int t = 8 * w + tt, tseq = n * 64 + t;
                float yq[2] = {0.f, 0.f}, yk[2] = {0.f, 0.f}, yv[2] = {0.f, 0.f};
#pragma unroll
                for (int j = 0; j < 4; ++j) {
                    if (tseq - 3 + j >= 0) {
                        const bf16* r = P + (row0 + t - 3 + j) * PW + h * 128 + lane;
#pragma unroll
                        for (int e = 0; e < 2; ++e) { yq[e] += cq[j][e] * bf2f(r[64 * e]); yk[e] += ck[j][e] * bf2f(r[512 + 64 * e]); yv[e] += cv[j][e] * bf2f(r[1024 + 64 * e]); }
                    }
                }
#pragma unroll
                for (int e = 0; e < 2; ++e) { yq[e] = silu_f(yq[e]); yk[e] = silu_f(yk[e]); yv[e] = silu_f(yv[e]); }
                const float rq = rsqrtf(wave_sum(yq[0] * yq[0] + yq[1] * yq[1]) + EPS) * 0.08838834764831845f;
                const float rk = rsqrtf(wave_sum(yk[0] * yk[0] + yk[1] * yk[1]) + EPS);
                const float bt = tab[64 + t], egt = tab[128 + t];
#pragma unroll
                for (int e = 0; e < 2; ++e) {
                    const int d = lane + 64 * e; const float qn = yq[e] * rq, kn = yk[e] * rk;
                    *(LAS unsigned short*)(L + CK_QB + t * 272 + 2 * d) = (unsigned short)f2bf(qn);
                    *(LAS unsigned short*)(L + CK_KB + t * 272 + 2 * d) = (unsigned short)f2bf(kn);
                    *(LAS unsigned short*)(L + CK_KT + d * 144 + 2 * t) = (unsigned short)f2bf(kn);
                    *(LAS unsigned short*)(L + CK_VBT + d * 144 + 2 * t) = (unsigned short)f2bf(yv[e] * bt);
                    *(LAS unsigned short*)(L + CK_KBET + d * 144 + 2 * t) = (unsigned short)f2bf(kn * bt * egt);
                }
            }
        }
        LDS_BAR();
        asm volatile("" : "+v"(lane)); li = lane & 15; lg = lane >> 4;
        if (w < 6) {
            const int mblk = (w < 3) ? w : (w < 5 ? 2 + ((w - 3) >> 1) * 0 : 3);
            const int mb2 = (w == 3) ? 2 : (w >= 4 ? 3 : w);
            const int s = (w == 3 || w == 5) ? 1 : 0;
            (void)mblk;
            f32x4 kk[2], qk[2];
#pragma unroll
            for (int hf = 0; hf < 2; ++hf) { kk[hf] = (f32x4){0.f, 0.f, 0.f, 0.f}; qk[hf] = (f32x4){0.f, 0.f, 0.f, 0.f}; }
#pragma unroll
            for (int hf = 0; hf < 2; ++hf) {
                const int cb = 2 * s + hf;
                if (cb <= mb2) {
#pragma unroll
                    for (int ks = 0; ks < 4; ++ks) {
                        const s16x8 a = *(const LAS s16x8*)(L + CK_KB + (16 * cb + li) * 272 + 64 * ks + 16 * lg);
                        const s16x8 bk = *(const LAS s16x8*)(L + CK_KB + (16 * mb2 + li) * 272 + 64 * ks + 16 * lg);
                        const s16x8 bq = *(const LAS s16x8*)(L + CK_QB + (16 * mb2 + li) * 272 + 64 * ks + 16 * lg);
                        kk[hf] = mma16(a, bk, kk[hf]); qk[hf] = mma16(a, bq, qk[hf]);
                    }
                }
            }
            const int i = 16 * mb2 + li; const float gci = tab[i], bi = tab[64 + i];
            f32x4 qv[2];
#pragma unroll
            for (int hf = 0; hf < 2; ++hf) {
                const int cb = 2 * s + hf;
#pragma unroll
                for (int r = 0; r < 4; ++r) {
                    const int j = 16 * cb + 4 * lg + r;
                    const float dec = __expf(fminf(gci - tab[j], 0.f));
                    qv[hf][r] = (i >= j) ? qk[hf][r] * dec : 0.f;
                    kk[hf][r] = (i > j) ? bi * kk[hf][r] * dec : 0.f;
                    if (cb <= mb2) *(LAS float*)(L + CK_AT + j * 272 + 4 * i) = kk[hf][r];
                }
                if (mb2 >= 2 && s == 0) { u32x2v o; o.x = pk2(kk[hf][0], kk[hf][1]); o.y = pk2(kk[hf][2], kk[hf][3]); *(LAS u32x2v*)(L + CK_LR + (i - 32) * 80 + (16 * cb + 4 * lg) * 2) = o; }
            }
            *(GAS v4u*)(QK + ((size_t)item * 8 + mb2 * 2 + s) * 512 + lane * 8) = __builtin_bit_cast(v4u, pack8f(qv[0], qv[1]));
        } else {
            *(GAS v4u*)(QK + ((size_t)item * 8 + (w == 6 ? 1 : 3)) * 512 + lane * 8) = (v4u){0u, 0u, 0u, 0u};
        }
        LDS_BAR();
        asm volatile("" : "+v"(lane)); li = lane & 15; lg = lane >> 4;
        if (w == 0) {
            const int half = lane >> 5, rl = lane & 31, base = 32 * half;
            float T[32];
#pragma unroll
            for (int j = 0; j < 32; ++j) T[j] = (j == rl) ? 1.f : 0.f;
#pragma unroll
            for (int c = 30; c >= 0; --c) {
                float a0 = 0.f, a1 = 0.f, a2 = 0.f, a3 = 0.f;
                unsigned aoff = (unsigned)(CK_AT + (base + c) * 272 + base * 4);
                if (c + 3 <= 31) asm volatile("" : "+v"(aoff) : "v"(T[c + 3]));
                const LAS float* ar = (const LAS float*)(L + aoff);
#pragma unroll
                for (int j4 = ((c + 1) >> 2); j4 < 8; ++j4) {
                    const f32x4 av = *(const LAS f32x4*)(ar + 4 * j4);
                    if (4 * j4 + 0 > c) a0 = fmaf(T[4 * j4 + 0], av[0], a0);
                    if (4 * j4 + 1 > c) a1 = fmaf(T[4 * j4 + 1], av[1], a1);
                    if (4 * j4 + 2 > c) a2 = fmaf(T[4 * j4 + 2], av[2], a2);
                    if (4 * j4 + 3 > c) a3 = fmaf(T[4 * j4 + 3], av[3], a3);
                }
                T[c] = (rl == c) ? 1.f : -((a0 + a1) + (a2 + a3));
            }
#pragma unroll
            for (int k8 = 0; k8 < 4; ++k8) {
                v4u o; o.x = pk2(T[8 * k8], T[8 * k8 + 1]); o.y = pk2(T[8 * k8 + 2], T[8 * k8 + 3]); o.z = pk2(T[8 * k8 + 4], T[8 * k8 + 5]); o.w = pk2(T[8 * k8 + 6], T[8 * k8 + 7]);
                *(LAS v4u*)(L + CK_TB + lane * 144 + 2 * base + 16 * k8) = o;
            }
            if (half == 0) {
#pragma unroll
                for (int k8 = 0; k8 < 4; ++k8) *(LAS v4u*)(L + CK_TB + lane * 144 + 64 + 16 * k8) = (v4u){0u, 0u, 0u, 0u};
#pragma unroll
                for (int c = 0; c < 32; ++c) *(LAS unsigned short*)(L + CK_T0T + c * 80 + 2 * rl) = (unsigned short)f2bf(T[c]);
            }
            asm volatile("s_waitcnt lgkmcnt(0)" ::: "memory");
            s16x8 lr[2], t0[2];
#pragma unroll
            for (int q = 0; q < 2; ++q) { lr[q] = *(const LAS s16x8*)(L + CK_LR + (16 * q + li) * 80 + 16 * lg); t0[q] = *(const LAS s16x8*)(L + CK_T0T + (16 * q + li) * 80 + 16 * lg); }
            s16x8 xb[2];
#pragma unroll
            for (int jb = 0; jb < 2; ++jb) { const f32x4 z4 = (f32x4){0.f, 0.f, 0.f, 0.f}; const f32x4 x0 = mma16(lr[0], t0[jb], z4), x1 = mma16(lr[1], t0[jb], z4); xb[jb] = pack8f(x0, x1); }
#pragma unroll
            for (int ib = 0; ib < 2; ++ib) {
                const u32x2v lo = *(const LAS u32x2v*)(L + CK_TB + (32 + 16 * ib + li) * 144 + (32 + 4 * lg) * 2), hi = *(const LAS u32x2v*)(L + CK_TB + (32 + 16 * ib + li) * 144 + (48 + 4 * lg) * 2);
                const s16x8 a = __builtin_bit_cast(s16x8, (v4u){lo.x, lo.y, hi.x, hi.y});
#pragma unroll
                for (int jb = 0; jb < 2; ++jb) { const f32x4 d = mma16(a, xb[jb], (f32x4){0.f, 0.f, 0.f, 0.f});
#pragma unroll
                    for (int r = 0; r < 4; ++r) *(LAS unsigned short*)(L + CK_TB + (32 + 16 * ib + 4 * lg + r) * 144 + 2 * (16 * jb + li)) = (unsigned short)f2bf(-d[r]); }
            }
        } else {
            for (int f = w - 1; f < 32; f += 7) {
                if (f < 16) {
                    const int mblk = f >> 2, s = f & 3, i = 16 * mblk + li; const float e = tab[128 + i];
                    const u32x2v lo = *(const LAS u32x2v*)(L + CK_QB + i * 272 + (32 * s + 4 * lg) * 2), hi = *(const LAS u32x2v*)(L + CK_QB + i * 272 + (32 * s + 16 + 4 * lg) * 2);
                    v4u o; o.x = pk2(bflo(lo.x) * e, bfhi(lo.x) * e); o.y = pk2(bflo(lo.y) * e, bfhi(lo.y) * e); o.z = pk2(bflo(hi.x) * e, bfhi(hi.x) * e); o.w = pk2(bflo(hi.y) * e, bfhi(hi.y) * e);
                    *(GAS v4u*)(QD + ((size_t)item * 16 + f) * 512 + lane * 8) = o;
                } else {
                    const int f2 = f - 16, dblk = f2 >> 1, s = f2 & 1, d = 16 * dblk + li, c0 = 32 * s + 4 * lg, c1 = c0 + 16;
                    const u32x2v lo = *(const LAS u32x2v*)(L + CK_KT + d * 144 + c0 * 2), hi = *(const LAS u32x2v*)(L + CK_KT + d * 144 + c1 * 2);
                    const f32x4 e0 = *(const LAS f32x4*)(tab + 192 + c0), e1 = *(const LAS f32x4*)(tab + 192 + c1);
                    v4u o; o.x = pk2(bflo(lo.x) * e0[0], bfhi(lo.x) * e0[1]); o.y = pk2(bflo(lo.y) * e0[2], bfhi(lo.y) * e0[3]); o.z = pk2(bflo(hi.x) * e1[0], bfhi(hi.x) * e1[1]); o.w = pk2(bflo(hi.y) * e1[2], bfhi(hi.y) * e1[3]);
                    *(GAS v4u*)(KDT + ((size_t)item * 16 + f2) * 512 + lane * 8) = o;
                }
            }
        }
        LDS_BAR();
        asm volatile("" : "+v"(lane)); li = lane & 15; lg = lane >> 4;
        {
            s16x8 tb[4][2];
#pragma unroll
            for (int mb = 0; mb < 4; ++mb)
#pragma unroll
                for (int s = 0; s < 2; ++s) tb[mb][s] = *(const LAS s16x8*)(L + CK_TB + (16 * mb + li) * 144 + 64 * s + 16 * lg);
            s16x8 vb[2], kb[2];
#pragma unroll
            for (int s = 0; s < 2; ++s) { vb[s] = *(const LAS s16x8*)(L + CK_VBT + (16 * w + li) * 144 + 64 * s + 16 * lg); kb[s] = *(const LAS s16x8*)(L + CK_KBET + (16 * w + li) * 144 + 64 * s + 16 * lg); }
#pragma unroll
            for (int mb = 0; mb < 4; ++mb) {
                f32x4 u = (f32x4){0.f, 0.f, 0.f, 0.f}, wv = (f32x4){0.f, 0.f, 0.f, 0.f};
#pragma unroll
                for (int s = 0; s < 2; ++s) { u = mma16(tb[mb][s], vb[s], u); wv = mma16(kb[s], tb[mb][s], wv); }
                *(GAS f32x4*)(U + (((size_t)item * 8 + w) * 4 + mb) * 256 + lane * 4) = u;
                u32x2v o; o.x = pk2(-wv[0], -wv[1]); o.y = pk2(-wv[2], -wv[3]);
                *(GAS u32x2v*)(WN + ((size_t)item * 16 + mb * 4 + (w >> 1)) * 512 + lane * 8 + 4 * (w & 1)) = o;
            }
        }
        LDS_BAR();
    }
}
constexpr int SC_BUFB = 57344, SC_PART = 2 * SC_BUFB;
__device__ __forceinline__ void gdn_scan(Frame& F, int bh, const bf16* WN, const bf16* QD, const bf16* KDT, const bf16* QK, const float* U, const float* GL, const float* ng, bf16* P) {
    LAS unsigned char* L = F.lds;
    LAS float* part = (LAS float*)(L + SC_PART);
    const int w = F.wave, lane = F.lane, li = lane & 15, lg = lane >> 4;
    const int b = bh >> 2, h = bh & 3;
    f32x4 S[8];
#pragma unroll
    for (int k = 0; k < 8; ++k) S[k] = (f32x4){0.f, 0.f, 0.f, 0.f};
    f32x4 ucur[4], unext[4], oprev[4];
#pragma unroll
    for (int k = 0; k < 4; ++k) { unext[k] = (f32x4){0.f, 0.f, 0.f, 0.f}; oprev[k] = (f32x4){0.f, 0.f, 0.f, 0.f}; }
#define SC_ISSUE(nn) do { const size_t ch_ = (size_t)bh * 32 + (nn); const int bo_ = ((nn) & 1) * SC_BUFB; \
        _Pragma("unroll") for (int k_ = 0; k_ < 7; ++k_) { const int p_ = w * 7 + k_; \
            const bf16* src_ = (p_ < 16) ? WN + (ch_ * 16 + p_) * 512 : (p_ < 32) ? QD + (ch_ * 16 + (p_ - 16)) * 512 : (p_ < 48) ? KDT + (ch_ * 16 + (p_ - 32)) * 512 : QK + (ch_ * 8 + (p_ - 48)) * 512; \
            __builtin_amdgcn_global_load_lds((const unsigned*)(src_ + lane * 8), (LAS unsigned*)(L + bo_ + p_ * 1024), 16, 0, 0); } \
        _Pragma("unroll") for (int mb_ = 0; mb_ < 4; ++mb_) unext[mb_] = *(const GAS f32x4*)(U + ((ch_ * 8 + w) * 4 + mb_) * 256 + lane * 4); } while (0)
#define SC_FINISH(nn) do { const LAS float* pp_ = part + ((nn) & 1) * 512; const float gcol_ = ng[16 * w + li]; const int col_ = h * 128 + 16 * w + li; \
        _Pragma("unroll") for (int mb_ = 0; mb_ < 4; ++mb_) _Pragma("unroll") for (int r_ = 0; r_ < 4; ++r_) { const int row_ = 16 * mb_ + 4 * lg + r_; \
            const f32x4 p0_ = *(const LAS f32x4*)(pp_ + row_ * 8), p1_ = *(const LAS f32x4*)(pp_ + row_ * 8 + 4); \
            const float tot_ = ((p0_[0] + p0_[1]) + (p0_[2] + p0_[3])) + ((p1_[0] + p1_[1]) + (p1_[2] + p1_[3])); \
            const float rs_ = rsqrtf(tot_ * (1.f / 128.f) + EPS); \
            bf16* pr_ = P + ((size_t)b * SEQ + (size_t)(nn) * 64 + row_) * PW; \
            const float z_ = bf2f(pr_[1536 + col_]); \
            pr_[col_] = (bf16)f2bf(oprev[mb_][r_] * rs_ * gcol_ * silu_f(z_)); } } while (0)
    SC_ISSUE(0);
    for (int n = 0; n < 32; ++n) {
        LDS_BAR();
#pragma unroll
        for (int k = 0; k < 4; ++k) ucur[k] = unext[k];
        if (n + 1 < 32) SC_ISSUE(n + 1);
        if (n > 0) SC_FINISH(n - 1);
        const LAS unsigned char* B = L + (n & 1) * SC_BUFB;
        s16x8 sb[4];
#pragma unroll
        for (int s = 0; s < 4; ++s) sb[s] = pack8f(S[2 * s], S[2 * s + 1]);
        f32x4 vn[4], o[4];
#pragma unroll
        for (int mb = 0; mb < 4; ++mb) { vn[mb] = ucur[mb]; o[mb] = (f32x4){0.f, 0.f, 0.f, 0.f}; }
#pragma unroll
        for (int mb = 0; mb < 4; ++mb)
#pragma unroll
            for (int s = 0; s < 4; ++s) {
                const s16x8 aw = *(const LAS s16x8*)(B + (mb * 4 + s) * 1024 + lane * 16);
                const s16x8 aq = *(const LAS s16x8*)(B + 16384 + (mb * 4 + s) * 1024 + lane * 16);
                vn[mb] = mma16(aw, sb[s], vn[mb]); o[mb] = mma16(aq, sb[s], o[mb]);
            }
        s16x8 vb[2];
#pragma unroll
        for (int s = 0; s < 2; ++s) vb[s] = pack8f(vn[2 * s], vn[2 * s + 1]);
#pragma unroll
        for (int mb = 0; mb < 4; ++mb)
#pragma unroll
            for (int s = 0; s < 2; ++s) { const s16x8 a = *(const LAS s16x8*)(B + 49152 + (mb * 2 + s) * 1024 + lane * 16); o[mb] = mma16(a, vb[s], o[mb]); }
        const float gl = GL[bh * 32 + n];
#pragma unroll
        for (int db = 0; db < 8; ++db) {
            S[db] = S[db] * gl;
#pragma unroll
            for (int s = 0; s < 2; ++s) { const s16x8 a = *(const LAS s16x8*)(B + 32768 + (db * 2 + s) * 1024 + lane * 16); S[db] = mma16(a, vb[s], S[db]); }
        }
        LAS float* pw = part + (n & 1) * 512;
#pragma unroll
        for (int mb = 0; mb < 4; ++mb)
#pragma unroll
            for (int r = 0; r < 4; ++r) { float p = o[mb][r] * o[mb][r]; p += __shfl_xor(p, 1); p += __shfl_xor(p, 2); p += __shfl_xor(p, 4); p += __shfl_xor(p, 8);
                if (li == 0) pw[(16 * mb + 4 * lg + r) * 8 + w] = p; }
#pragma unroll
        for (int k = 0; k < 4; ++k) oprev[k] = o[k];
    }
    LDS_BAR();
    SC_FINISH(31);
    LDS_BAR();
#undef SC_ISSUE
#undef SC_FINISH
}

typedef float f32x16 __attribute__((ext_vector_type(16)));
typedef short v4i16_t __attribute__((ext_vector_type(4)));
__device__ __forceinline__ f32x16 mma32(s16x8 a, s16x8 b, f32x16 c) { return __builtin_amdgcn_mfma_f32_32x32x16_bf16(a, b, c, 0, 0, 0); }
constexpr int SW_OACC = 0, SW_MACC = 65536, SW_LACC = 66560, SW_WSCR = 67584, SW_WSZ = 5120;
__device__ __forceinline__ void swa_unit(Frame& F, bf16* P, int unit) {
    LAS unsigned char* L = F.lds;
    LAS float* Oacc = (LAS float*)(L + SW_OACC); LAS float* Macc = (LAS float*)(L + SW_MACC); LAS float* Lacc = (LAS float*)(L + SW_LACC);
    const int w = F.wave;
    int lane = F.lane; asm volatile("" : "+v"(lane));
    const int r = lane & 31, hh = lane >> 5;
    LAS unsigned char* vt = L + SW_WSCR + w * SW_WSZ; LAS float* sc = (LAS float*)(vt + 4608);
    const int tb = unit & 7, h = (unit >> 3) & 7, b = unit >> 6, t0 = tb * 256;
    const float slope2 = exp2f(-(float)(h + 1)) * 1.4426950408889634f;
    const bf16* base = P + (size_t)b * SEQ * PW + 2048 + h * 64;
    for (int pass = 0; pass < 3; ++pass) {
        const int d = (pass == 0) ? 1 : (pass == 1 ? 4 : 16), dsh = 2 * pass;
        const int nrb = (pass == 2) ? 2 : 1;
        for (int ri = 0; ri < nrb; ++ri) {
            int c, qs0;
            if (pass == 0) { c = 0; qs0 = t0 + 32 * w; } else if (pass == 1) { c = w >> 1; qs0 = (t0 >> 2) + 32 * (w & 1); } else { c = 2 * w + ri; qs0 = (t0 >> 4) & ~31; }
            const int tq = ((qs0 + r) << dsh) + c;
            s16x8 qf[4];
            { const bf16* qp = base + (size_t)tq * PW + 8 * hh;
#pragma unroll
              for (int s = 0; s < 4; ++s) qf[s] = *(const GAS s16x8*)(qp + 16 * s); }
            f32x16 o0, o1;
#pragma unroll
            for (int v = 0; v < 16; ++v) { o0[v] = 0.f; o1[v] = 0.f; }
            float mrun = -INFINITY, lrun = 0.f;
            const int kb0 = qs0 >> 5;
            for (int kb = kb0; kb >= 0 && kb >= kb0 - 4; --kb) {
                const int ks0 = kb * 32;
                const int tk = ((ks0 + r) << dsh) + c;
                s16x8 kf[4];
                { const bf16* kp = base + (size_t)tk * PW + 512 + 8 * hh;
#pragma unroll
                  for (int s = 0; s < 4; ++s) kf[s] = *(const GAS s16x8*)(kp + 16 * s); }
                { const int vk = lane >> 1, vh = lane & 1; const bf16* vp = base + (size_t)((((ks0 + vk) << dsh) + c)) * PW + 1024 + 32 * vh;
#pragma unroll
                  for (int i = 0; i < 4; ++i) { const v4u x = *(const GAS v4u*)(vp + 8 * i); *(LAS v4u*)(vt + vk * 144 + vh * 64 + 16 * i) = x; } }
                f32x16 st;
#pragma unroll
                for (int v = 0; v < 16; ++v) st[v] = 0.f;
#pragma unroll
                for (int s = 0; s < 4; ++s) st = mma32(kf[s], qf[s], st);
                const int qsub = qs0 + r;
                float bm = -INFINITY;
#pragma unroll
                for (int v = 0; v < 16; ++v) {
                    const int ksub = ks0 + (v & 3) + 8 * (v >> 2) + 4 * hh, dl = qsub - ksub;
                    const float x = st[v] * 0.18033688011112042f - slope2 * (float)(dl << dsh);
                    st[v] = (dl >= 0 && dl <= 128) ? x : -INFINITY;
                    bm = fmaxf(bm, st[v]);
                }
                bm = fmaxf(bm, __shfl_xor(bm, 32));
                const float mn = fmaxf(mrun, bm);
                const float alpha = exp2f(mrun - mn);
                float rs = 0.f;
#pragma unroll
                for (int v = 0; v < 16; ++v) { st[v] = exp2f(st[v] - mn); rs += st[v]; }
                rs += __shfl_xor(rs, 32);
                lrun = lrun * alpha + rs; mrun = mn;
                if (hh == 0) sc[r] = alpha;
                asm volatile("s_waitcnt lgkmcnt(0)" ::: "memory");
                s16x8 pf[2];
#pragma unroll
                for (int s = 0; s < 2; ++s) { v4u x; x.x = pk2(st[8 * s], st[8 * s + 1]); x.y = pk2(st[8 * s + 2], st[8 * s + 3]); x.z = pk2(st[8 * s + 4], st[8 * s + 5]); x.w = pk2(st[8 * s + 6], st[8 * s + 7]); pf[s] = __builtin_bit_cast(s16x8, x); }
#pragma unroll
                for (int g4 = 0; g4 < 4; ++g4) { const f32x4 a4 = *(const LAS f32x4*)(sc + 8 * g4 + 4 * hh);
#pragma unroll
                    for (int e = 0; e < 4; ++e) { o0[4 * g4 + e] *= a4[e]; o1[4 * g4 + e] *= a4[e]; } }
                { const int gi = lane & 15, q = gi >> 2, p4 = gi & 3, G = lane >> 4; const int dimb = 16 * (G & 1) + 4 * p4;
#pragma unroll
                  for (int s = 0; s < 2; ++s)
#pragma unroll
                      for (int nb = 0; nb < 2; ++nb) {
                          const LAS unsigned char* a0 = vt + (16 * s + 4 * hh + q) * 144 + (dimb + 32 * nb) * 2;
                          const v4i16_t lo = __builtin_amdgcn_ds_read_tr16_b64_v4i16((LAS v4i16_t*)a0), hi = __builtin_amdgcn_ds_read_tr16_b64_v4i16((LAS v4i16_t*)(a0 + 8 * 144));
                          const s16x8 vf = (s16x8){lo[0], lo[1], lo[2], lo[3], hi[0], hi[1], hi[2], hi[3]};
                          if (nb == 0) o0 = mma32(pf[s], vf, o0); else o1 = mma32(pf[s], vf, o1);
                      } }
                asm volatile("s_waitcnt lgkmcnt(0)" ::: "memory");
            }
            if (hh == 0) { sc[32 + r] = mrun; sc[64 + r] = lrun; }
            asm volatile("s_waitcnt lgkmcnt(0)" ::: "memory");
#pragma unroll
            for (int v = 0; v < 16; ++v) {
                const int qr = (v & 3) + 8 * (v >> 2) + 4 * hh;
                const int tl = ((qs0 + qr) << dsh) + c - t0;
                if (tl >= 0 && tl < 256) {
                    const float mb = sc[32 + qr];
                    if (pass == 0) { Oacc[tl * 64 + r] = o0[v]; Oacc[tl * 64 + 32 + r] = o1[v]; if (r == 0) { Macc[tl] = mb; Lacc[tl] = sc[64 + qr]; } }
                    else { const float mo = Macc[tl], mn = fmaxf(mo, mb), fo = exp2f(mo - mn), fb = exp2f(mb - mn);
                        Oacc[tl * 64 + r] = Oacc[tl * 64 + r] * fo + o0[v] * fb; Oacc[tl * 64 + 32 + r] = Oacc[tl * 64 + 32 + r] * fo + o1[v] * fb;
                        asm volatile("s_waitcnt lgkmcnt(0)" ::: "memory");
                        if (r == 0) { Lacc[tl] = Lacc[tl] * fo + sc[64 + qr] * fb; Macc[tl] = mn; } }
                }
            }
            asm volatile("s_waitcnt lgkmcnt(0)" ::: "memory");
        }
        LDS_BAR();
    }
    { const int tl = F.tid >> 1, hf = F.tid & 1; const float il = 1.f / Lacc[tl];
      bf16* op = P + ((size_t)b * SEQ + t0 + tl) * PW + 512 + h * 64 + 32 * hf;
#pragma unroll
      for (int i = 0; i < 4; ++i) { const f32x4 x0 = *(const LAS f32x4*)(Oacc + tl * 64 + 32 * hf + 8 * i), x1 = *(const LAS f32x4*)(Oacc + tl * 64 + 32 * hf + 8 * i + 4);
          v4u o; o.x = pk2(x0[0] * il, x0[1] * il); o.y = pk2(x0[2] * il, x0[3] * il); o.z = pk2(x1[0] * il, x1[1] * il); o.w = pk2(x1[2] * il, x1[3] * il);
          *(GAS v4u*)(op + 8 * i) = o; } }
    LDS_BAR();
}

constexpr int XA_K = 0, XA_V = 16896, XA_SC = 33792;
__device__ __forceinline__ void xattn_unit(Frame& F, const bf16* Q, const bf16* KM, const bf16* VM, bf16* O, int unit) {
    LAS unsigned char* L = F.lds;
    const int w = F.wave;
    int lane = F.lane; asm volatile("" : "+v"(lane));
    int tid = F.tid; asm volatile("" : "+v"(tid));
    const int r = lane & 31, hh = lane >> 5;
    LAS float* sc = (LAS float*)(L + XA_SC + w * 128);
    const int qb = unit & 7, hd = (unit >> 3) & 3, b = unit >> 5;
    const size_t qrow = (size_t)b * SEQ + qb * 256 + w * 32 + r;
    const bf16* qp = Q + qrow * DM + hd * 256 + 8 * hh;
    f32x16 o[8];
#pragma unroll
    for (int nb = 0; nb < 8; ++nb)
#pragma unroll
        for (int v = 0; v < 16; ++v) o[nb][v] = 0.f;
    float mrun = -INFINITY, lrun = 0.f;
    for (int kb = 0; kb < 8; ++kb) {
        LDS_BAR();
#pragma unroll
        for (int i = 0; i < 2; ++i) { const int pc = tid + 512 * i, key = pc >> 5, ch = pc & 31;
            const size_t src = ((size_t)b * NMEM + kb * 32 + key) * DM + hd * 256 + ch * 8;
            const v4u kx = *(const GAS v4u*)(KM + src), vx = *(const GAS v4u*)(VM + src);
            *(LAS v4u*)(L + XA_K + key * 528 + ch * 16) = kx; *(LAS v4u*)(L + XA_V + key * 528 + ch * 16) = vx; }
        LDS_BAR();
        f32x16 st;
#pragma unroll
        for (int v = 0; v < 16; ++v) st[v] = 0.f;
#pragma unroll
        for (int s = 0; s < 16; ++s) { const s16x8 a = *(const LAS s16x8*)(L + XA_K + r * 528 + 32 * s + 16 * hh); const s16x8 bq = *(const GAS s16x8*)(qp + 16 * s); st = mma32(a, bq, st); }
        float bm = -INFINITY;
#pragma unroll
        for (int v = 0; v < 16; ++v) { st[v] *= 0.09016844005556021f; bm = fmaxf(bm, st[v]); }
        bm = fmaxf(bm, __shfl_xor(bm, 32));
        const float mn = fmaxf(mrun, bm), alpha = exp2f(mrun - mn);
        float rs = 0.f;
#pragma unroll
        for (int v = 0; v < 16; ++v) { st[v] = exp2f(st[v] - mn); rs += st[v]; }
        rs += __shfl_xor(rs, 32);
        lrun = lrun * alpha + rs; mrun = mn;
        if (hh == 0) sc[r] = alpha;
        asm volatile("s_waitcnt lgkmcnt(0)" ::: "memory");
        s16x8 pf[2];
#pragma unroll
        for (int s = 0; s < 2; ++s) { v4u x; x.x = pk2(st[8 * s], st[8 * s + 1]); x.y = pk2(st[8 * s + 2], st[8 * s + 3]); x.z = pk2(st[8 * s + 4], st[8 * s + 5]); x.w = pk2(st[8 * s + 6], st[8 * s + 7]); pf[s] = __builtin_bit_cast(s16x8, x); }
        f32x4 a4[4];
#pragma unroll
        for (int g4 = 0; g4 < 4; ++g4) a4[g4] = *(const LAS f32x4*)(sc + 8 * g4 + 4 * hh);
        const int gi = lane & 15, q = gi >> 2, p4 = gi & 3, G = lane >> 4; const int dimb = 16 * (G & 1) + 4 * p4;
#pragma unroll
        for (int nb = 0; nb < 8; ++nb) {
#pragma unroll
            for (int g4 = 0; g4 < 4; ++g4)
#pragma unroll
                for (int e = 0; e < 4; ++e) o[nb][4 * g4 + e] *= a4[g4][e];
#pragma unroll
            for (int s = 0; s < 2; ++s) {
                const LAS unsigned char* a0 = L + XA_V + (16 * s + 4 * hh + q) * 528 + (dimb + 32 * nb) * 2;
                const v4i16_t lo = __builtin_amdgcn_ds_read_tr16_b64_v4i16((LAS v4i16_t*)a0), hi = __builtin_amdgcn_ds_read_tr16_b64_v4i16((LAS v4i16_t*)(a0 + 8 * 528));
                const s16x8 vf = (s16x8){lo[0], lo[1], lo[2], lo[3], hi[0], hi[1], hi[2], hi[3]};
                o[nb] = mma32(pf[s], vf, o[nb]);
            }
        }
    }
    if (hh == 0) sc[r] = 1.f / lrun;
    asm volatile("s_waitcnt lgkmcnt(0)" ::: "memory");
    f32x4 il[4];
#pragma unroll
    for (int g4 = 0; g4 < 4; ++g4) il[g4] = *(const LAS f32x4*)(sc + 8 * g4 + 4 * hh);
    bf16* ob = O + ((size_t)b * SEQ + qb * 256 + w * 32) * DM + hd * 256 + r;
#pragma unroll
    for (int nb = 0; nb < 8; ++nb)
#pragma unroll
        for (int v = 0; v < 16; ++v) { const int qr = (v & 3) + 8 * (v >> 2) + 4 * hh; ob[(size_t)qr * DM + 32 * nb] = (bf16)f2bf(o[nb][v] * il[v >> 2][v & 3]); }
    LDS_BAR();
}

struct Args { const float* in[27]; float* out; unsigned char* ws; };
__global__ void __launch_bounds__(NTHREADS, 2) mk_fwd(Args args) {
    extern __shared__ __attribute__((aligned(16))) unsigned char lds[];
    Frame F;
    F.lds = (LAS unsigned char*)lds;
    F.MISC = (volatile LAS unsigned*)(F.lds + MISC_OFF);
    F.tid = threadIdx.x; F.lane = F.tid & 63; F.wave = __builtin_amdgcn_readfirstlane(F.tid >> 6);
    F.G = gridDim.x; { const int bx = blockIdx.x; F.vcu = (F.G % 8 == 0) ? (bx % 8) * (F.G / 8) + bx / 8 : bx; }
    unsigned char* ws = args.ws;
    F.ctl = (gu32*)(ws + WS_CTL);
    for (int u = F.tid; u < (LDS_BYTES - LDSCTL_OFF) / 4; u += NTHREADS) ((LAS unsigned*)(F.lds + LDSCTL_OFF))[u] = 0u;
    __syncthreads();
    XcdBarrier bar = xcd_barrier_post((unsigned*)(F.ctl + CW_BAR), F.MISC + 8);
#define GRID_BAR() do { xcd_barrier(bar); F.tid = threadIdx.x; asm volatile("" : "+v"(F.tid)); F.lane = F.tid & 63; } while (0)
    float* out = (float*)INP(27);
    bf16* XN = (bf16*)(ws + WS_XN); bf16* HB = (bf16*)(ws + WS_HB); bf16* PROJ = (bf16*)(ws + WS_PROJ); bf16* T1 = (bf16*)(ws + WS_T1); bf16* QB = (bf16*)(ws + WS_Q);
    bf16* KM = (bf16*)(ws + WS_KM); bf16* VM = (bf16*)(ws + WS_VM); float* AB = (float*)(ws + WS_AB);
    const int bid = (int)blockIdx.x;

    enum { K_PRO = 0, K_SWIGLU, K_GBF16, K_NORM, K_PROJ, K_CHUNK, K_SCAN, K_XATTN };
#pragma unroll 1
    for (int ph = 0; ph < 16; ++ph) {
        int kind = K_PRO; size_t wA = 0, wB = 0, wO = 0; int K = DM, lda = DM; int gx = 0, g1 = 0, g2 = -1; float sc = 1.f;
        switch (ph) {
            case 0:  kind = K_PRO; break;
            case 1:  kind = K_SWIGLU; wB = WS_W1GU; break;
            case 2:  kind = K_GBF16; wA = WS_HB; wB = WS_W1D; wO = WS_T1; K = DFF; lda = DFF; break;
            case 3:  kind = K_NORM; gx = 0; g1 = 6; g2 = 7; sc = 0.5f; break;
            case 4:  kind = K_PROJ; break;
            case 5:  kind = K_CHUNK; break;
            case 6:  kind = K_SCAN; break;
            case 7:  kind = K_GBF16; wA = WS_PROJ; wB = WS_WOUT; wO = WS_T1; K = DM; lda = PW; break;
            case 8:  kind = K_NORM; gx = 27; g1 = 14; g2 = 15; break;
            case 9:  kind = K_GBF16; wA = WS_XN; wB = WS_WQ; wO = WS_Q; break;
            case 10: kind = K_XATTN; break;
            case 11: kind = K_GBF16; wA = WS_XN; wB = WS_WO; wO = WS_T1; break;
            case 12: kind = K_NORM; gx = 27; g1 = 21; g2 = 22; break;
            case 13: kind = K_SWIGLU; wB = WS_W2GU; break;
            case 14: kind = K_GBF16; wA = WS_HB; wB = WS_W2D; wO = WS_T1; K = DFF; lda = DFF; break;
            default: kind = K_NORM; gx = 27; g1 = 26; g2 = -1; sc = 0.5f; break;
        }
        if (kind == K_PRO) p0_prologue(F, ws);
        else if (kind == K_SWIGLU) { pg8::Gemm g{XN, (const bf16*)(ws + wB), MTOK, 2 * DFF, DM, DM}; pg8::StaticOrder S; S.init(MTOK, 2 * DFF, F.G, bid); pg8::EpiSwiglu E{HB, DFF};
            pg8::gemm_phase<pg8::EpiSwiglu, pg8::StaticOrder, true, true>(F.lds + RING_OFF, g, S, E); }
        else if (kind == K_GBF16) { pg8::Gemm g{(const bf16*)(ws + wA), (const bf16*)(ws + wB), MTOK, DM, K, lda}; pg8::StaticOrder S; S.init(MTOK, DM, F.G, bid); pg8::EpiBf16 E{(bf16*)(ws + wO), DM};
            pg8::gemm_phase<pg8::EpiBf16, pg8::StaticOrder, true, true>(F.lds + RING_OFF, g, S, E); }
        else if (kind == K_NORM) norm_pass(F, INP(gx), T1, INP(g1), sc, out, g2 >= 0 ? INP(g2) : nullptr, XN);
        else if (kind == K_PROJ) { pg8::Gemm g{XN, (const bf16*)(ws + WS_WIN), MTOK + MMEM, 3840 + 2048, DM, DM}; pg8::ProjKvOrder S; S.init(F.G, bid); pg8::EpiProjKv E{PROJ, AB, KM, VM};
            pg8::gemm_phase<pg8::EpiProjKv, pg8::ProjKvOrder, true, true>(F.lds + RING_OFF, g, S, E); }
        else if (kind == K_CHUNK) gdn_chunk(F, PROJ, AB, INP(9), INP(10), INP(11), (bf16*)(ws + WS_CWN), (bf16*)(ws + WS_CQD), (bf16*)(ws + WS_CKDT), (bf16*)(ws + WS_CQK), (float*)(ws + WS_CU), (float*)(ws + WS_GL));
        else if (kind == K_SCAN) { if (bid < 32) gdn_scan(F, bid, (const bf16*)(ws + WS_CWN), (const bf16*)(ws + WS_CQD), (const bf16*)(ws + WS_CKDT), (const bf16*)(ws + WS_CQK), (const float*)(ws + WS_CU), (const float*)(ws + WS_GL), INP(12), PROJ);
                                   else { for (int u = bid - 32; u < NBATCH * 8 * 8; u += F.G - 32) swa_unit(F, PROJ, u); } }
        else { for (int u = F.vcu; u < NBATCH * 4 * 8; u += F.G) xattn_unit(F, QB, KM, VM, XN, u); }
        if (ph < 15) GRID_BAR();
    }
#undef GRID_BAR
}

extern "C" void kernel_launch(void* const* d_in, const int* in_sizes, int n_in, void* d_out, int out_size, void* d_ws, size_t ws_size, hipStream_t stream) {
    static int grid = 0;
    if (grid == 0) {
        if (n_in != 27 || out_size != MTOK * DM || ws_size < WS_END) { fprintf(stderr, "kernel_launch: unexpected shapes (n_in %d, out %d, ws %zu)\n", n_in, out_size, ws_size); grid = -1; return; }
        int dev = 0, cus = 0, per_cu = 0;
        if (hipGetDevice(&dev) != hipSuccess || hipDeviceGetAttribute(&cus, hipDeviceAttributeMultiprocessorCount, dev) != hipSuccess) { grid = -1; return; }
        if (hipFuncSetAttribute((const void*)mk_fwd, hipFuncAttributeMaxDynamicSharedMemorySize, LDS_BYTES) != hipSuccess) { fprintf(stderr, "kernel_launch: hipFuncSetAttribute failed\n"); grid = -1; return; }
        if (hipOccupancyMaxActiveBlocksPerMultiprocessor(&per_cu, (const void*)mk_fwd, NTHREADS, LDS_BYTES) != hipSuccess || per_cu < 1) fprintf(stderr, "kernel_launch: occupancy query reports %d\n", per_cu);
        (void)hipGetLastError();
        grid = cus;
    }
    if (grid < 0) return;
    if (hipMemsetAsync((char*)d_ws + WS_CTL, 0, CTL_ZERO_BYTES, stream) != hipSuccess) return;
    Args a{};
    for (int i = 0; i < 27; ++i) a.in[i] = (const float*)d_in[i];
    a.out = (float*)d_out; a.ws = (unsigned char*)d_ws;
    hipLaunchKernelGGL(mk_fwd, dim3(grid), dim3(NTHREADS), LDS_BYTES, stream, a);
}
```

```cpp
#include <hip/hip_runtime.h>
#include <cstdio>
#include <cstdint>
#include <cmath>
namespace pg8 {
#define PG8_LAS __attribute__((address_space(3)))
typedef unsigned short bf16_t;
typedef short bf16x8 __attribute__((ext_vector_type(8)));
typedef float f32x4 __attribute__((ext_vector_type(4)));
typedef unsigned u32x4 __attribute__((ext_vector_type(4)));
constexpr int BM = 256, BK = 64, HALF = 128, HTB = HALF * BK * 2  , STAGE_BYTES = 8 * HTB, NXCD = 8, WGM = 8;
__host__ __device__ __forceinline__ int lds_byte(int r, int c) { const int st = (r >> 4) * 2 + (c >> 5), rr = r & 15, cc = c & 31, ob = rr * 64 + cc * 2; return st * 1024 + (ob ^ (((ob >> 9) & 1) << 5)); }
__host__ __device__ __forceinline__ void stage_rc(int b, int& R, int& C) { const int st = b / 1024, sb = b % 1024, swz = sb ^ (((sb >> 9) & 1) << 5); R = (st >> 1) * 16 + swz / 64; C = (st & 1) * 32 + (swz % 64) / 2; }
__host__ __device__ __forceinline__ int perm32(int rho) { const int n = rho >> 4, i = rho & 15; return 8 * (i >> 2) + 4 * n + (i & 3); }
struct Unit { int pm, pn; };
struct Gemm { const bf16_t* A; const bf16_t* Bt; int M, N, K, lda; };

struct StaticOrder {
    int nM, nN, nwg, G, c;
    __host__ __device__ void init(int M, int N, int G_, int c_) { nM = M / BM; nN = N / BM; nwg = nM * nN; G = G_; c = c_; }
    __host__ __device__ bool next(int i, Unit& u) const {
        const long L = (long)i * G + c; if (L >= nwg) return false;
        int wgid = (int)L; { const int q = nwg / NXCD, r = nwg % NXCD, xcd = wgid % NXCD, off = wgid / NXCD; wgid = (xcd < r ? xcd * (q + 1) : r * (q + 1) + (xcd - r) * q) + off; }
        const int nig = WGM * nN, gid = wgid / nig, fm = gid * WGM, gsz = (nM - fm) < WGM ? (nM - fm) : WGM;
        u.pm = fm + ((wgid % nig) % gsz); u.pn = (wgid % nig) / gsz; return true;
    }
    __device__ __forceinline__ void a_ready(const Unit&) const {}
    __device__ __forceinline__ void done(const Unit&) const {}
};
struct ProjKvOrder {
    StaticOrder so; int G, c;
    __host__ __device__ void init(int G_, int c_) { so.init(16384, 3840, G_, c_); G = G_; c = c_; }
    __host__ __device__ bool next(int i, Unit& u) const {
        if (so.next(i, u)) return true;
        const long kv = (long)i * G + c - so.nwg; if (kv < 0 || kv >= 64) return false;
        u.pm = 64 + (int)(kv & 7); u.pn = 15 + (int)(kv >> 3); return true;
    }
    __device__ __forceinline__ void a_ready(const Unit&) const {}
    __device__ __forceinline__ void done(const Unit&) const {}
};

__device__ __forceinline__ unsigned cvt_pk_bf16(float lo, float hi) { unsigned r; asm volatile("v_cvt_pk_bf16_f32 %0, %1, %2" : "=v"(r) : "v"(lo), "v"(hi)); return r; }
__device__ __forceinline__ float fast_silu(float x) { return x * __builtin_amdgcn_rcpf(1.0f + __builtin_amdgcn_exp2f(-1.4426950408889634f * x)); }
__device__ __forceinline__ u32x4 pack8(const f32x4 a, const f32x4 b) { u32x4 w; w.x = cvt_pk_bf16(a[0], a[1]); w.y = cvt_pk_bf16(a[2], a[3]); w.z = cvt_pk_bf16(b[0], b[1]); w.w = cvt_pk_bf16(b[2], b[3]); return w; }

struct EpiBf16 {
    static constexpr bool PERM = true, AFTER_DRAIN = false;
    bf16_t* O; int ldc;
    __device__ __forceinline__ void operator()(const f32x4 (&acc)[2][2][4][2], const Unit& u, int wr, int wc, int fr, int fq) const {
        const int row0 = u.pm * BM + wr * 64 + fr, col0 = u.pn * BM + wc * 32 + 8 * fq;
#pragma unroll
        for (int ai = 0; ai < 2; ++ai)
#pragma unroll
            for (int m = 0; m < 4; ++m) { bf16_t* rowp = O + (size_t)(row0 + ai * HALF + m * 16) * ldc + col0;
#pragma unroll
                for (int bj = 0; bj < 2; ++bj) *(u32x4*)(rowp + bj * HALF) = pack8(acc[ai][bj][m][0], acc[ai][bj][m][1]); }
    }
};
struct EpiSwiglu {
    static constexpr bool PERM = true, AFTER_DRAIN = false;
    bf16_t* O; int ldc;
    __device__ __forceinline__ void operator()(const f32x4 (&acc)[2][2][4][2], const Unit& u, int wr, int wc, int fr, int fq) const {
        const int row0 = u.pm * BM + wr * 64 + fr, col0 = u.pn * HALF + wc * 32 + 8 * fq;
#pragma unroll
        for (int ai = 0; ai < 2; ++ai)
#pragma unroll
            for (int m = 0; m < 4; ++m) { bf16_t* rowp = O + (size_t)(row0 + ai * HALF + m * 16) * ldc + col0;
                f32x4 h0, h1;
#pragma unroll
                for (int e = 0; e < 4; ++e) { h0[e] = fast_silu(acc[ai][0][m][0][e]) * acc[ai][1][m][0][e]; h1[e] = fast_silu(acc[ai][0][m][1][e]) * acc[ai][1][m][1][e]; }
                *(u32x4*)rowp = pack8(h0, h1); }
    }
};
struct EpiProjKv {
    static constexpr bool PERM = true, AFTER_DRAIN = false;
    bf16_t* P; float* AB; bf16_t* KM; bf16_t* VM;
    __device__ __forceinline__ void operator()(const f32x4 (&acc)[2][2][4][2], const Unit& u, int wr, int wc, int fr, int fq) const {
        if (u.pn < 14) {
            const int row0 = u.pm * BM + wr * 64 + fr, col0 = u.pn * BM + wc * 32 + 8 * fq;
#pragma unroll
            for (int ai = 0; ai < 2; ++ai)
#pragma unroll
                for (int m = 0; m < 4; ++m) { bf16_t* rowp = P + (size_t)(row0 + ai * HALF + m * 16) * 3584 + col0;
#pragma unroll
                    for (int bj = 0; bj < 2; ++bj) *(u32x4*)(rowp + bj * HALF) = pack8(acc[ai][bj][m][0], acc[ai][bj][m][1]); }
        } else if (u.pn == 14) {
            if (wc == 0 && fq == 0) {
                const int row0 = u.pm * BM + wr * 64 + fr;
#pragma unroll
                for (int ai = 0; ai < 2; ++ai)
#pragma unroll
                    for (int m = 0; m < 4; ++m) { float* rowp = AB + (size_t)(row0 + ai * HALF + m * 16) * 8; *(f32x4*)rowp = acc[ai][0][m][0]; *(f32x4*)(rowp + 4) = acc[ai][0][m][1]; }
            }
        } else {
            const int row0 = (u.pm - 64) * BM + wr * 64 + fr; int ct = (u.pn - 15) * BM; bf16_t* base = KM; if (ct >= 1024) { ct -= 1024; base = VM; }
            const int col0 = ct + wc * 32 + 8 * fq;
#pragma unroll
            for (int ai = 0; ai < 2; ++ai)
#pragma unroll
                for (int m = 0; m < 4; ++m) { bf16_t* rowp = base + (size_t)(row0 + ai * HALF + m * 16) * 1024 + col0;
#pragma unroll
                    for (int bj = 0; bj < 2; ++bj) *(u32x4*)(rowp + bj * HALF) = pack8(acc[ai][bj][m][0], acc[ai][bj][m][1]); }
        }
    }
};

template <class Epi, class Sched, bool ALIGN_EPI = false, bool SP2 = false>
__device__ __forceinline__ void gemm_phase(PG8_LAS unsigned char* lds, const Gemm g, const Sched& S, const Epi& E) {
    int tid_ = threadIdx.x; asm volatile("" : "+v"(tid_));
    const int tid = tid_, wid = __builtin_amdgcn_readfirstlane(tid >> 6), lane = tid & 63, wr = wid >> 2, wc = wid & 3, fr = lane & 15, fq = lane >> 4;
    const int K = g.K, nt = K / BK;
    unsigned voffA[2], voffB[2];
#pragma unroll
    for (int i = 0; i < 2; ++i) { int R, C; stage_rc(tid * 16 + i * 8192, R, C); const int Rb = Epi::PERM ? ((R & ~31) + perm32(R & 31)) : R;
        voffA[i] = (unsigned)(R * g.lda + C) * 2u; voffB[i] = (unsigned)(Rb * K + C) * 2u; }
    const size_t kstep = (size_t)(BK * 2);
    const size_t hstepA = (size_t)HALF * g.lda * 2, hstepB = (size_t)HALF * K * 2;
    const size_t tstepA = 2 * hstepA, tstepB = 2 * hstepB;
    const unsigned ldsw = (unsigned)wid * 1024u;
    const int aoff = lds_byte(wr * 64 + fr, fq * 8), boff = lds_byte(wc * 32 + fr, fq * 8);
#define PG8_SA(b, h) (((b) * 2 + (h)) * HTB)
#define PG8_SB(b, h) ((4 + (b) * 2 + (h)) * HTB)
#define PG8_STAGE(bufoff, gbase, voff) do { _Pragma("unroll") for (int _i = 0; _i < 2; ++_i) \
        __builtin_amdgcn_global_load_lds((const unsigned*)((const char*)(gbase) + (voff)[_i]), (PG8_LAS unsigned*)(lds + (bufoff) + ldsw + _i * 8192), 16, 0, 0); } while (0)
#define PG8_LDA(dst, b, h) do { _Pragma("unroll") for (int m = 0; m < 4; ++m) _Pragma("unroll") for (int k = 0; k < 2; ++k) dst[m][k] = *(const PG8_LAS bf16x8*)(lds + PG8_SA(b, h) + aoff + m * 2048 + k * 1024); } while (0)
#define PG8_LDB(dst, b, h) do { _Pragma("unroll") for (int n = 0; n < 2; ++n) _Pragma("unroll") for (int k = 0; k < 2; ++k) dst[n][k] = *(const PG8_LAS bf16x8*)(lds + PG8_SB(b, h) + boff + n * 2048 + k * 1024); } while (0)
#define PG8_MMA(ai, bj, At, Bt) do { __builtin_amdgcn_s_setprio(1); _Pragma("unroll") for (int m = 0; m < 4; ++m) _Pragma("unroll") for (int n = 0; n < 2; ++n) _Pragma("unroll") for (int k = 0; k < 2; ++k) \
        acc[ai][bj][m][n] = __builtin_amdgcn_mfma_f32_16x16x32_bf16(Bt[n][k], At[m][k], acc[ai][bj][m][n], 0, 0, 0); __builtin_amdgcn_s_setprio(0); } while (0)
#define PG8_WAIT_V(n) asm volatile("s_waitcnt vmcnt(" #n ")" ::: "memory")
#define PG8_WAIT_L(n) asm volatile("s_waitcnt lgkmcnt(" #n ")" ::: "memory")
#define PG8_BAR __builtin_amdgcn_s_barrier()
#define PG8_SCHED __builtin_amdgcn_sched_barrier(0)
    Unit cur, nxt; int ui = 0;
    if (!S.next(0, cur)) return;
    f32x4 acc[2][2][4][2];
#pragma unroll
    for (int a = 0; a < 2; ++a)
#pragma unroll
        for (int b = 0; b < 2; ++b)
#pragma unroll
            for (int m = 0; m < 4; ++m)
#pragma unroll
                for (int n = 0; n < 2; ++n) acc[a][b][m][n] = (f32x4){0.f, 0.f, 0.f, 0.f};
    bf16x8 At[4][2], B0[2][2], B1[2][2];
    const char* cA = (const char*)g.A + (size_t)cur.pm * tstepA; const char* cB = (const char*)g.Bt + (size_t)cur.pn * tstepB;
    S.a_ready(cur);
    if constexpr (SP2) {
        PG8_STAGE(PG8_SB(0, 0), cB, voffB); PG8_STAGE(PG8_SB(0, 1), cB + hstepB, voffB); PG8_STAGE(PG8_SA(0, 0), cA, voffA); PG8_STAGE(PG8_SA(0, 1), cA + hstepA, voffA);
        if (wr == 1) PG8_BAR;
        PG8_WAIT_V(2); PG8_BAR;
        PG8_STAGE(PG8_SB(1, 0), cB + kstep, voffB); PG8_STAGE(PG8_SA(1, 0), cA + kstep, voffA); PG8_STAGE(PG8_SB(1, 1), cB + hstepB + kstep, voffB);
        PG8_WAIT_V(6); PG8_BAR;
    } else {
        PG8_STAGE(PG8_SB(0, 0), cB, voffB); PG8_STAGE(PG8_SA(0, 0), cA, voffA); PG8_STAGE(PG8_SB(0, 1), cB + hstepB, voffB); PG8_STAGE(PG8_SA(0, 1), cA + hstepA, voffA);
        if (wr == 1) PG8_BAR;
        PG8_WAIT_V(4); PG8_BAR;
        PG8_STAGE(PG8_SB(1, 0), cB + kstep, voffB); PG8_STAGE(PG8_SA(1, 0), cA + kstep, voffA); PG8_STAGE(PG8_SB(1, 1), cB + hstepB + kstep, voffB);
        PG8_WAIT_V(6); PG8_BAR;
    }
    for (;;) {
        const bool has_next = S.next(ui + 1, nxt);
        const char* nA = has_next ? (const char*)g.A + (size_t)nxt.pm * tstepA : cA; const char* nB = has_next ? (const char*)g.Bt + (size_t)nxt.pn * tstepB : cB;
        for (int t = 0; t < nt; t += 2) {
            const bool last = (t == nt - 2);
            const char* a1 = cA + (size_t)(t + 1) * kstep;
            const char* a2 = last ? nA : cA + (size_t)(t + 2) * kstep; const char* b2 = last ? nB : cB + (size_t)(t + 2) * kstep;
            const char* a3 = a2 + kstep; const char* b3 = b2 + kstep;
            if (last && has_next) S.a_ready(nxt);
            if constexpr (SP2) {
            PG8_LDB(B0, 0, 0); PG8_LDB(B1, 0, 1); PG8_SCHED; PG8_LDA(At, 0, 0); PG8_STAGE(PG8_SA(1, 1), a1 + hstepA, voffA);
            PG8_WAIT_V(8); PG8_WAIT_L(0); PG8_BAR; PG8_MMA(0, 0, At, B0); PG8_MMA(0, 1, At, B1); PG8_BAR; PG8_SCHED;
            PG8_LDA(At, 0, 1); PG8_STAGE(PG8_SB(0, 0), b2, voffB); PG8_STAGE(PG8_SB(0, 1), b2 + hstepB, voffB); PG8_STAGE(PG8_SA(0, 0), a2, voffA);
            PG8_WAIT_V(8); PG8_WAIT_L(0); PG8_BAR; PG8_MMA(1, 0, At, B0); PG8_MMA(1, 1, At, B1); PG8_BAR; PG8_SCHED;
            PG8_LDB(B0, 1, 0); PG8_LDB(B1, 1, 1); PG8_SCHED; PG8_LDA(At, 1, 0); PG8_STAGE(PG8_SA(0, 1), a2 + hstepA, voffA);
            PG8_WAIT_V(8); PG8_WAIT_L(0); PG8_BAR; PG8_MMA(0, 0, At, B0); PG8_MMA(0, 1, At, B1); PG8_BAR; PG8_SCHED;
            PG8_LDA(At, 1, 1); PG8_STAGE(PG8_SB(1, 0), b3, voffB); PG8_STAGE(PG8_SB(1, 1), b3 + hstepB, voffB); PG8_STAGE(PG8_SA(1, 0), a3, voffA);
            PG8_WAIT_V(8); PG8_WAIT_L(0); PG8_BAR; PG8_MMA(1, 0, At, B0); PG8_MMA(1, 1, At, B1); PG8_BAR; PG8_SCHED;
            } else {
            PG8_LDB(B0, 0, 0); PG8_SCHED; PG8_LDA(At, 0, 0); PG8_STAGE(PG8_SA(1, 1), a1 + hstepA, voffA);
            PG8_WAIT_L(8); PG8_BAR; PG8_WAIT_L(0); PG8_MMA(0, 0, At, B0); PG8_BAR; PG8_SCHED;
            PG8_LDB(B1, 0, 1); PG8_STAGE(PG8_SB(0, 0), b2, voffB);
            PG8_BAR; PG8_WAIT_L(0); PG8_MMA(0, 1, At, B1); PG8_BAR;
            PG8_LDA(At, 0, 1); PG8_STAGE(PG8_SA(0, 0), a2, voffA);
            PG8_BAR; PG8_WAIT_L(0); PG8_MMA(1, 0, At, B0); PG8_BAR; PG8_SCHED;
            PG8_STAGE(PG8_SB(0, 1), b2 + hstepB, voffB);
            PG8_WAIT_V(6); PG8_BAR; PG8_MMA(1, 1, At, B1); PG8_BAR;
            PG8_LDB(B0, 1, 0); PG8_SCHED; PG8_LDA(At, 1, 0); PG8_STAGE(PG8_SA(0, 1), a2 + hstepA, voffA);
            PG8_WAIT_L(8); PG8_BAR; PG8_WAIT_L(0); PG8_MMA(0, 0, At, B0); PG8_BAR; PG8_SCHED;
            PG8_LDB(B1, 1, 1); PG8_STAGE(PG8_SB(1, 0), b3, voffB);
            PG8_BAR; PG8_WAIT_L(0); PG8_MMA(0, 1, At, B1); PG8_BAR;
            PG8_LDA(At, 1, 1); PG8_STAGE(PG8_SA(1, 0), a3, voffA);
            PG8_BAR; PG8_WAIT_L(0); PG8_MMA(1, 0, At, B0); PG8_BAR; PG8_SCHED;
            PG8_STAGE(PG8_SB(1, 1), b3 + hstepB, voffB);
            PG8_WAIT_V(6); PG8_BAR; PG8_MMA(1, 1, At, B1); PG8_BAR;
            }
        }
        if constexpr (ALIGN_EPI) { if (wr == 0) PG8_BAR; }
        if constexpr (!Epi::AFTER_DRAIN) { E(acc, cur, wr, wc, fr, fq); S.done(cur); }
        if (!has_next) break;
#pragma unroll
        for (int a = 0; a < 2; ++a)
#pragma unroll
            for (int b = 0; b < 2; ++b)
#pragma unroll
                for (int m = 0; m < 4; ++m)
#pragma unroll
                    for (int n = 0; n < 2; ++n) acc[a][b][m][n] = (f32x4){0.f, 0.f, 0.f, 0.f};
        cur = nxt; cA = nA; cB = nB; ++ui;
        if constexpr (ALIGN_EPI) { if (wr == 1) PG8_BAR; }
    }
    PG8_WAIT_V(0);
    if constexpr (!ALIGN_EPI) { if (wr == 0) PG8_BAR; }
    PG8_BAR;
    if constexpr (Epi::AFTER_DRAIN) { E.fused(acc, cur, wr, wc, fr, fq, lds, wid, lane); S.done(cur); }
#undef PG8_SA
#undef PG8_SB
#undef PG8_STAGE
#undef PG8_LDA
#undef PG8_LDB
#undef PG8_MMA
#undef PG8_WAIT_V
#undef PG8_WAIT_L
#undef PG8_BAR
#undef PG8_SCHED
}
}
#define GAS __attribute__((address_space(1)))
#define LAS __attribute__((address_space(3)))
typedef unsigned short bf16;
typedef unsigned v4u __attribute__((ext_vector_type(4)));
typedef float f32x4 __attribute__((ext_vector_type(4)));
typedef short bf16x8 __attribute__((ext_vector_type(8)));
typedef GAS unsigned gu32;
typedef GAS unsigned long long gu64;
#define RLX_AGENT __ATOMIC_RELAXED, __HIP_MEMORY_SCOPE_AGENT
#define LDS_WAIT() asm volatile("s_waitcnt lgkmcnt(0)" ::: "memory")
#define VM_WAIT() asm volatile("s_waitcnt vmcnt(0)" ::: "memory")
__device__ __forceinline__ unsigned long long rt() { return __builtin_amdgcn_s_memrealtime(); }
__device__ __forceinline__ unsigned f2bf(float f) { unsigned u = __builtin_bit_cast(unsigned, f); return (u + 0x7fffu + ((u >> 16) & 1u)) >> 16; }
__device__ __forceinline__ unsigned pk2(float lo, float hi) { return f2bf(lo) | (f2bf(hi) << 16); }

#define XB_TMO      128
#define XB_XCNT(j)  (256  + 64 * (j))
#define XB_XSUB(j)  (1280 + 64 * (j))
#define XB_XGEN(j)  (2304 + 64 * (j))
#define XB_TOP      3328
#define XB_TOPGEN   3392
#define XCD_BAR_WORDS 3456
#define XB_SPIN_CAP (1u << 18)

__device__ __forceinline__ unsigned xb_ld(unsigned* p)              { return __hip_atomic_load(p, __ATOMIC_RELAXED, __HIP_MEMORY_SCOPE_AGENT); }
__device__ __forceinline__ unsigned xb_add(unsigned* p, unsigned v) { return __hip_atomic_fetch_add(p, v, __ATOMIC_RELAXED, __HIP_MEMORY_SCOPE_AGENT); }
__device__ __forceinline__ unsigned xb_xcc_id() { return (unsigned)__builtin_amdgcn_s_getreg((3 << 11) | 20) & 0xFu; }
#define XB_SPIN(cond, bar) do { unsigned _sp = 0; while (cond) { __builtin_amdgcn_s_sleep(1); \
    if ((++_sp & 255u) == 0u) { if (xb_ld(&(bar)[XB_TMO])) break; if (_sp > XB_SPIN_CAP) { atomicAdd(&(bar)[XB_TMO], 1u); break; } } } } while (0)

struct XcdBarrier {
    unsigned* bar; unsigned x;
    volatile LAS unsigned* st;
};

__device__ __forceinline__ XcdBarrier xcd_barrier_post(unsigned* bar, volatile LAS unsigned* st) {
    XcdBarrier b; b.bar = bar; b.x = xb_xcc_id(); b.st = st;
    if (threadIdx.x == 0) (void)xb_add(&bar[XB_XCNT(b.x)], 1u);
    return b;
}
__device__ __forceinline__ void xcd_barrier_complete(unsigned* bar, unsigned x, unsigned& nloc, unsigned& nx) {
    const unsigned G = gridDim.x * gridDim.y * gridDim.z;
    unsigned sum, cnt, mine, sp = 0u;
    for (;;) {
        sum = 0u; cnt = 0u; mine = 0u;
#pragma unroll
        for (unsigned j = 0; j < 16; ++j) { const unsigned c = xb_ld(&bar[XB_XCNT(j)]); sum += c; cnt += (c > 0u) ? 1u : 0u; mine = (j == x) ? c : mine; }
        if (sum == G) break;
        __builtin_amdgcn_s_sleep(1);
        if ((++sp & 255u) == 0u) { if (xb_ld(&bar[XB_TMO])) break; if (sp > XB_SPIN_CAP) { atomicAdd(&bar[XB_TMO], 1u); break; } }
    }
    nloc = mine > 0u ? mine : 1u; nx = cnt > 0u ? cnt : 1u;
}

__device__ __forceinline__ void xcd_barrier(const XcdBarrier& b) {
    asm volatile("s_waitcnt vmcnt(0)" ::: "memory");
    __syncthreads();
    if (threadIdx.x == 0) {
        unsigned* bar = b.bar;
        __builtin_amdgcn_s_waitcnt(0);
        unsigned nloc = b.st[0], nx = b.st[1];
        if (nloc == 0u) { xcd_barrier_complete(bar, b.x, nloc, nx); b.st[0] = nloc; b.st[1] = nx; }
        const unsigned old = xb_add(&bar[XB_XSUB(b.x)], 1u);
        const unsigned gen = old / nloc;
        if (old + 1u == (gen + 1u) * nloc) {
            __builtin_amdgcn_fence(__ATOMIC_RELEASE, "agent");
            asm volatile("s_waitcnt vmcnt(0)" ::: "memory");
            const unsigned og = xb_add(&bar[XB_TOP], 1u);
            const unsigned tg = og / nx;
            if (og + 1u == (tg + 1u) * nx) xb_add(&bar[XB_TOPGEN], 1u);
            else XB_SPIN(xb_ld(&bar[XB_TOPGEN]) == tg, bar);
            __builtin_amdgcn_fence(__ATOMIC_ACQUIRE, "agent");
            xb_add(&bar[XB_XGEN(b.x)], 1u);
            asm volatile("s_waitcnt vmcnt(0)" ::: "memory");
        } else {
            XB_SPIN(xb_ld(&bar[XB_XGEN(b.x)]) == gen, bar);
            __builtin_amdgcn_fence(__ATOMIC_ACQUIRE, "agent");
            asm volatile("s_waitcnt vmcnt(0)" ::: "memory");
        }
    }
    __syncthreads();
}

constexpr int NWAVES = 8, NTHREADS = 512;
constexpr int DM = 1024, NBATCH = 8, SEQ = 2048, MTOK = NBATCH * SEQ, NMEM = 256, MMEM = NBATCH * NMEM, DFF = 2816, INC = 3592;
constexpr int PW = 3584;
constexpr float EPS = 1e-6f;
constexpr size_t MiB = 1u << 20;
constexpr size_t WS_CTL = 0, CTL_ZERO_BYTES = 1 * MiB;
constexpr size_t WS_W1GU = 1 * MiB, WS_W1D = 12 * MiB, WS_WIN = 35 * MiB / 2, WS_WKV = 25 * MiB, WS_WOUT = 29 * MiB, WS_WQ = 31 * MiB, WS_WO = 33 * MiB, WS_W2GU = 35 * MiB, WS_W2D = 46 * MiB;
constexpr size_t WS_XN = 52 * MiB;
constexpr size_t WS_QN = 52 * MiB, WS_KN = 68 * MiB;
constexpr size_t WS_BIG = 88 * MiB;
constexpr size_t WS_HB = 88 * MiB;
constexpr size_t WS_PROJ = 88 * MiB;
constexpr size_t WS_Q = 88 * MiB;
constexpr size_t WS_T1 = 200 * MiB;
constexpr size_t WS_VV = 200 * MiB;
constexpr size_t WS_AB = 232 * MiB, WS_BETA = 233 * MiB, WS_GG = 234 * MiB;
constexpr size_t WS_CHKA = 1 * MiB, WS_CHKB = 52 * MiB, WS_CU = 200 * MiB, WS_GL = 235 * MiB;
constexpr size_t WS_KM = 240 * MiB, WS_VM = 244 * MiB, WS_END = 248 * MiB;
static_assert(WS_WIN + (size_t)3840 * 1024 * 2 == WS_WKV, "Wkv rows must directly follow Win rows");
constexpr int CW_BAR = 4096;
constexpr int RING_OFF = 0, RING_BYTES = 131072, LDSCTL_OFF = RING_BYTES, MISC_OFF = LDSCTL_OFF + 320, LDS_BYTES = 147456;

struct Frame {
    LAS unsigned char* lds; volatile LAS unsigned* MISC; gu32* ctl;
    int tid, lane, wave, vcu, G;
};
template <int CTRL> __device__ __forceinline__ float dpp_mov(float v) { return __uint_as_float((unsigned)__builtin_amdgcn_update_dpp(0, (int)__float_as_uint(v), CTRL, 0xF, 0xF, true)); }
__device__ __forceinline__ float row16_sum(float v) { v += dpp_mov<0xB1>(v); v += dpp_mov<0x4E>(v); v += dpp_mov<0x141>(v); v += dpp_mov<0x140>(v); return v; }
__device__ __forceinline__ float row16_max(float v) { v = fmaxf(v, dpp_mov<0xB1>(v)); v = fmaxf(v, dpp_mov<0x4E>(v)); v = fmaxf(v, dpp_mov<0x141>(v)); v = fmaxf(v, dpp_mov<0x140>(v)); return v; }
__device__ __forceinline__ float rdlane(float v, int l) { return __uint_as_float((unsigned)__builtin_amdgcn_readlane((int)__float_as_uint(v), l)); }
__device__ __forceinline__ float wave_sum(float v) { v = row16_sum(v); return (rdlane(v, 0) + rdlane(v, 16)) + (rdlane(v, 32) + rdlane(v, 48)); }
__device__ __forceinline__ float wave_max(float v) { v = row16_max(v); return fmaxf(fmaxf(rdlane(v, 0), rdlane(v, 16)), fmaxf(rdlane(v, 32), rdlane(v, 48))); }
__device__ __forceinline__ float bf2f(unsigned short b) { return __uint_as_float((unsigned)b << 16); }
__device__ __forceinline__ float bflo(unsigned w) { return __uint_as_float(w << 16); }
__device__ __forceinline__ float bfhi(unsigned w) { return __uint_as_float(w & 0xffff0000u); }
__device__ __forceinline__ float silu_f(float x) { return x / (1.f + __expf(-x)); }

__device__ __forceinline__ void transpose_item(const float* W, int ldw, int K, int k0, int srcbase, int nvalid, bf16* WT, int dstrow0, LAS float* scr, int lane) {
    const int nl = lane & 31; const bool ok = nl < nvalid;
#pragma unroll 8
    for (int i = 0; i < 32; ++i) { const int kk = 2 * i + (lane >> 5); scr[kk * 33 + nl] = ok ? W[(size_t)(k0 + kk) * ldw + srcbase + nl] : 0.f; }
    LDS_WAIT(); asm volatile("" ::: "memory");
    const int c = lane & 7;
#pragma unroll
    for (int j = 0; j < 4; ++j) { const int n = (lane >> 3) + 8 * j; const LAS float* s = scr + (8 * c) * 33 + n;
        v4u o; o.x = pk2(s[0 * 33], s[1 * 33]); o.y = pk2(s[2 * 33], s[3 * 33]); o.z = pk2(s[4 * 33], s[5 * 33]); o.w = pk2(s[6 * 33], s[7 * 33]);
        *(GAS v4u*)(WT + (size_t)(dstrow0 + n) * K + k0 + 8 * c) = o; }
    LDS_WAIT(); asm volatile("" ::: "memory");
}
__device__ __forceinline__ void conv_gu(const float* wg, const float* wu, bf16* WT, LAS float* scr, int it, int lane) {
    const int which = it / 1408, r = it % 1408, kb = r / 88, nb = r % 88, n0 = nb * 32;
    transpose_item(which ? wu : wg, DFF, DM, kb * 64, n0, 32, WT, 256 * (n0 >> 7) + (which ? 128 : 0) + (n0 & 127), scr, lane);
}
__device__ __forceinline__ void conv_plain(const float* w, int K, int N, bf16* WT, int rowoff, LAS float* scr, int it, int lane) {
    const int nblk = N / 32, kb = it / nblk, nb = it % nblk;
    transpose_item(w, N, K, kb * 64, nb * 32, 32, WT, rowoff + nb * 32, scr, lane);
}
__device__ __forceinline__ void conv_win(const float* w, bf16* WT, LAS float* scr, int it, int lane) {
    const int kb = it / 120, db = it % 120, d0 = db * 32;
    int srcbase = d0, nvalid = 32;
    if (d0 >= 2048 && d0 < 3584) srcbase = d0 + 8; else if (d0 == 3584) { srcbase = 2048; nvalid = 8; } else if (d0 > 3584) { srcbase = 0; nvalid = 0; }
    transpose_item(w, INC, DM, kb * 64, srcbase, nvalid, WT, d0, scr, lane);
}
__device__ __forceinline__ void norm_row_bf16(const float* xrow, const float* g, bf16* orow, int lane) {
    const GAS f32x4* xr = (const GAS f32x4*)xrow + lane; const GAS f32x4* gr = (const GAS f32x4*)g + lane;
    f32x4 v[4]; float s = 0.f;
#pragma unroll
    for (int j = 0; j < 4; ++j) { v[j] = xr[64 * j]; s += (v[j].x * v[j].x + v[j].y * v[j].y) + (v[j].z * v[j].z + v[j].w * v[j].w); }
    const float r = rsqrtf(wave_sum(s) * (1.f / DM) + EPS);
    GAS unsigned long long* o8 = (GAS unsigned long long*)orow + lane;
#pragma unroll
    for (int j = 0; j < 4; ++j) { const f32x4 gg = gr[64 * j]; o8[64 * j] = (unsigned long long)pk2(v[j].x * r * gg.x, v[j].y * r * gg.y) | ((unsigned long long)pk2(v[j].z * r * gg.z, v[j].w * r * gg.w) << 32); }
}
__device__ __forceinline__ const float* inptr(int i) { const char* ka = (const char*)__builtin_amdgcn_kernarg_segment_ptr(); int off = i * 8; asm volatile("" : "+s"(off)); return *(const float* const*)(ka + off); }
#define INP(i) inptr(i)
__device__ __forceinline__ void p0_prologue(Frame& F, unsigned char* ws) {
    LAS float* scr = (LAS float*)(F.lds + RING_OFF + F.wave * 16384);
    const int gw = F.vcu * NWAVES + F.wave, NGW = F.G * NWAVES;
    constexpr int I_GU = 2 * 16 * 88, I_D = 44 * 32, I_IN = 16 * 120, I_SQ = 16 * 32;
    constexpr int NITEMS = 2 * I_GU + 2 * I_D + I_IN + 5 * I_SQ;
    for (int it = gw; it < NITEMS; it += NGW) {
        int r = it;
        if (r < I_GU) { conv_gu(INP(3), INP(4), (bf16*)(ws + WS_W1GU), scr, r, F.lane); continue; } r -= I_GU;
        if (r < I_D) { conv_plain(INP(5), DFF, DM, (bf16*)(ws + WS_W1D), 0, scr, r, F.lane); continue; } r -= I_D;
        if (r < I_IN) { conv_win(INP(8), (bf16*)(ws + WS_WIN), scr, r, F.lane); continue; } r -= I_IN;
        if (r < I_SQ) { conv_plain(INP(18), DM, DM, (bf16*)(ws + WS_WKV), 0, scr, r, F.lane); continue; } r -= I_SQ;
        if (r < I_SQ) { conv_plain(INP(19), DM, DM, (bf16*)(ws + WS_WKV), 1024, scr, r, F.lane); continue; } r -= I_SQ;
        if (r < I_SQ) { conv_plain(INP(13), DM, DM, (bf16*)(ws + WS_WOUT), 0, scr, r, F.lane); continue; } r -= I_SQ;
        if (r < I_SQ) { conv_plain(INP(17), DM, DM, (bf16*)(ws + WS_WQ), 0, scr, r, F.lane); continue; } r -= I_SQ;
        if (r < I_SQ) { conv_plain(INP(20), DM, DM, (bf16*)(ws + WS_WO), 0, scr, r, F.lane); continue; } r -= I_SQ;
        if (r < I_GU) { conv_gu(INP(23), INP(24), (bf16*)(ws + WS_W2GU), scr, r, F.lane); continue; } r -= I_GU;
        conv_plain(INP(25), DFF, DM, (bf16*)(ws + WS_W2D), 0, scr, r, F.lane);
    }
    bf16* XN = (bf16*)(ws + WS_XN);
    for (int m = gw; m < MTOK + MMEM; m += NGW) {
        if (m < MTOK) norm_row_bf16(INP(0) + (size_t)m * DM, INP(2), XN + (size_t)m * DM, F.lane);
        else norm_row_bf16(INP(1) + (size_t)(m - MTOK) * DM, INP(16), XN + (size_t)m * DM, F.lane);
    }
}
__device__ __forceinline__ void norm_pass(Frame& F, const float* xin, const bf16* f, const float* g1, float scale, float* xout, const float* g2, bf16* XN) {
    const int gw = F.vcu * NWAVES + F.wave, NGW = F.G * NWAVES;
    for (int m = gw; m < MTOK; m += NGW) {
        const GAS f32x4* xr = (const GAS f32x4*)(xin + (size_t)m * DM) + F.lane;
        const GAS unsigned long long* fr = (const GAS unsigned long long*)(f + (size_t)m * DM) + F.lane;
        const GAS f32x4* g1r = (const GAS f32x4*)g1 + F.lane;
        f32x4 fv[4]; float s = 0.f;
#pragma unroll
        for (int j = 0; j < 4; ++j) { const unsigned long long w = fr[64 * j]; const unsigned lo = (unsigned)w, hi = (unsigned)(w >> 32);
            fv[j] = (f32x4){bflo(lo), bfhi(lo), bflo(hi), bfhi(hi)}; s += (fv[j].x * fv[j].x + fv[j].y * fv[j].y) + (fv[j].z * fv[j].z + fv[j].w * fv[j].w); }
        const float r1 = rsqrtf(wave_sum(s) * (1.f / DM) + EPS) * scale;
        float s2 = 0.f;
        GAS f32x4* xo = (GAS f32x4*)(xout + (size_t)m * DM) + F.lane;
#pragma unroll
        for (int j = 0; j < 4; ++j) { const f32x4 xx = xr[64 * j]; const f32x4 gg = g1r[64 * j];
            fv[j] = xx + fv[j] * gg * r1; s2 += (fv[j].x * fv[j].x + fv[j].y * fv[j].y) + (fv[j].z * fv[j].z + fv[j].w * fv[j].w); xo[64 * j] = fv[j]; }
        if (g2) {
            const float r2 = rsqrtf(wave_sum(s2) * (1.f / DM) + EPS);
            const GAS f32x4* g2r = (const GAS f32x4*)g2 + F.lane;
            GAS unsigned long long* o8 = (GAS unsigned long long*)(XN + (size_t)m * DM) + F.lane;
#pragma unroll
            for (int j = 0; j < 4; ++j) { const f32x4 gg = g2r[64 * j]; o8[64 * j] = (unsigned long long)pk2(fv[j].x * r2 * gg.x, fv[j].y * r2 * gg.y) | ((unsigned long long)pk2(fv[j].z * r2 * gg.z, fv[j].w * r2 * gg.w) << 32); }
        }
    }
}
__device__ __forceinline__ void swa_naive(Frame& F, bf16* P, int wg, int nwg) {
    for (int idx = wg * NTHREADS + F.tid; idx < MTOK * 8; idx += nwg * NTHREADS) {
        const int t = idx & (SEQ - 1), h = (idx >> 11) & 7, b = idx >> 14;
        const float slope = exp2f(-(float)(h + 1));
        const bf16* base = P + (size_t)b * SEQ * PW;
        float q[64], o[64];
        { const v4u* qp = (const v4u*)(base + (size_t)t * PW + 2048 + h * 64);
#pragma unroll
          for (int i = 0; i < 8; ++i) { const v4u w = qp[i]; q[8 * i] = bflo(w.x); q[8 * i + 1] = bfhi(w.x); q[8 * i + 2] = bflo(w.y); q[8 * i + 3] = bfhi(w.y); q[8 * i + 4] = bflo(w.z); q[8 * i + 5] = bfhi(w.z); q[8 * i + 6] = bflo(w.w); q[8 * i + 7] = bfhi(w.w); } }
#pragma unroll
        for (int i = 0; i < 64; ++i) o[i] = 0.f;
        float m = -INFINITY, l = 0.f;
        for (int br = 0; br < 3; ++br) {
            const int dil = (br == 0) ? 1 : (br == 1 ? 4 : 16);
            for (int dl = 0; dl <= 128; ++dl) {
                const int tk = t - dl * dil;
                if (tk < 0) break;
                const v4u* kp = (const v4u*)(base + (size_t)tk * PW + 2560 + h * 64);
                float s = 0.f;
#pragma unroll
                for (int i = 0; i < 8; ++i) { const v4u w = kp[i];
                    s = fmaf(q[8 * i], bflo(w.x), s); s = fmaf(q[8 * i + 1], bfhi(w.x), s); s = fmaf(q[8 * i + 2], bflo(w.y), s); s = fmaf(q[8 * i + 3], bfhi(w.y), s);
                    s = fmaf(q[8 * i + 4], bflo(w.z), s); s = fmaf(q[8 * i + 5], bfhi(w.z), s); s = fmaf(q[8 * i + 6], bflo(w.w), s); s = fmaf(q[8 * i + 7], bfhi(w.w), s); }
                s = s * 0.125f - slope * (float)(dil * dl);
                const float mn = fmaxf(m, s);
                const float c = __expf(m - mn), p = __expf(s - mn);
                l = l * c + p; m = mn;
                const v4u* vp = (const v4u*)(base + (size_t)tk * PW + 3072 + h * 64);
#pragma unroll
                for (int i = 0; i < 8; ++i) { const v4u w = vp[i];
                    o[8 * i] = o[8 * i] * c + p * bflo(w.x); o[8 * i + 1] = o[8 * i + 1] * c + p * bfhi(w.x); o[8 * i + 2] = o[8 * i + 2] * c + p * bflo(w.y); o[8 * i + 3] = o[8 * i + 3] * c + p * bfhi(w.y);
                    o[8 * i + 4] = o[8 * i + 4] * c + p * bflo(w.z); o[8 * i + 5] = o[8 * i + 5] * c + p * bfhi(w.z); o[8 * i + 6] = o[8 * i + 6] * c + p * bflo(w.w); o[8 * i + 7] = o[8 * i + 7] * c + p * bfhi(w.w); }
            }
        }
        const float il = 1.f / l;
        v4u* op = (v4u*)(P + ((size_t)b * SEQ + t) * PW + 512 + h * 64);
#pragma unroll
        for (int i = 0; i < 8; ++i) { v4u w; w.x = pk2(o[8 * i] * il, o[8 * i + 1] * il); w.y = pk2(o[8 * i + 2] * il, o[8 * i + 3] * il); w.z = pk2(o[8 * i + 4] * il, o[8 * i + 5] * il); w.w = pk2(o[8 * i + 6] * il, o[8 * i + 7] * il); op[i] = w; }
    }
}
__device__ __forceinline__ void xattn_naive(Frame& F, const bf16* Q, const bf16* KM, const bf16* VM, bf16* O) {
    LAS float* qs = (LAS float*)F.lds;
    LAS float* ps = qs + 2048;
    const int tid = F.tid, w = F.wave, lane = F.lane, rr = w >> 2, hd = w & 3;
    for (int rp = F.vcu; rp < MTOK / 2; rp += F.G) {
        const size_t row0 = (size_t)rp * 2;
        { const unsigned long long wq = *(const unsigned long long*)(Q + row0 * DM + tid * 4); const unsigned lo = (unsigned)wq, hi = (unsigned)(wq >> 32);
          qs[tid * 4] = bflo(lo); qs[tid * 4 + 1] = bfhi(lo); qs[tid * 4 + 2] = bflo(hi); qs[tid * 4 + 3] = bfhi(hi); }
        __syncthreads();
        const size_t row = row0 + rr; const int b = (int)(row >> 11);
        float sc[4];
#pragma unroll
        for (int i = 0; i < 4; ++i) {
            const int mk = lane + 64 * i;
            const v4u* kp = (const v4u*)(KM + ((size_t)b * NMEM + mk) * DM + hd * 256);
            const LAS float* qq = qs + rr * 1024 + hd * 256;
            float s = 0.f;
            for (int d8 = 0; d8 < 32; ++d8) { const v4u kw = kp[d8];
                s = fmaf(qq[8 * d8], bflo(kw.x), s); s = fmaf(qq[8 * d8 + 1], bfhi(kw.x), s); s = fmaf(qq[8 * d8 + 2], bflo(kw.y), s); s = fmaf(qq[8 * d8 + 3], bfhi(kw.y), s);
                s = fmaf(qq[8 * d8 + 4], bflo(kw.z), s); s = fmaf(qq[8 * d8 + 5], bfhi(kw.z), s); s = fmaf(qq[8 * d8 + 6], bflo(kw.w), s); s = fmaf(qq[8 * d8 + 7], bfhi(kw.w), s); }
            sc[i] = s * 0.0625f;
        }
        const float mx = wave_max(fmaxf(fmaxf(sc[0], sc[1]), fmaxf(sc[2], sc[3])));
        float e[4]; float sum = 0.f;
#pragma unroll
        for (int i = 0; i < 4; ++i) { e[i] = __expf(sc[i] - mx); sum += e[i]; }
        const float inv = 1.f / wave_sum(sum);
#pragma unroll
        for (int i = 0; i < 4; ++i) ps[w * 256 + lane + 64 * i] = e[i] * inv;
        __syncthreads();
        float a0 = 0.f, a1 = 0.f, a2 = 0.f, a3 = 0.f;
        for (int mk = 0; mk < NMEM; ++mk) {
            const float p = ps[w * 256 + mk];
            const unsigned long long vw = *(const unsigned long long*)(VM + ((size_t)b * NMEM + mk) * DM + hd * 256 + lane * 4); const unsigned lo = (unsigned)vw, hi = (unsigned)(vw >> 32);
            a0 = fmaf(p, bflo(lo), a0); a1 = fmaf(p, bfhi(lo), a1); a2 = fmaf(p, bflo(hi), a2); a3 = fmaf(p, bfhi(hi), a3);
        }
        *(unsigned long long*)(O + row * DM + hd * 256 + lane * 4) = (unsigned long long)pk2(a0, a1) | ((unsigned long long)pk2(a2, a3) << 32);
        __syncthreads();
    }
}

typedef short s16x8 __attribute__((ext_vector_type(8)));
typedef unsigned u32x2v __attribute__((ext_vector_type(2)));
__device__ __forceinline__ f32x4 mma16(s16x8 a, s16x8 b, f32x4 c) { return __builtin_amdgcn_mfma_f32_16x16x32_bf16(a, b, c, 0, 0, 0); }
__device__ __forceinline__ s16x8 pack8f(const f32x4 a, const f32x4 b) { v4u w; w.x = pk2(a[0], a[1]); w.y = pk2(a[2], a[3]); w.z = pk2(b[0], b[1]); w.w = pk2(b[2], b[3]); return __builtin_bit_cast(s16x8, w); }
#define LDSO_BAR() do { asm volatile("s_waitcnt lgkmcnt(0)" ::: "memory"); __builtin_amdgcn_s_barrier(); asm volatile("" ::: "memory"); } while (0)
#define LDS_BAR() do { asm volatile("s_waitcnt vmcnt(0) lgkmcnt(0)" ::: "memory"); __builtin_amdgcn_s_barrier(); asm volatile("" ::: "memory"); } while (0)
constexpr int CK_QB = 0, CK_KB = 17408, CK_KT = 34816, CK_VBT = 53248, CK_KBET = 71680, CK_AT = 90112, CK_TB = 107520, CK_TAB = 116736, CK_LR = 117760, CK_T0T = 120320;
__device__ __forceinline__ void gdn_chunk(Frame& F, const bf16* P, const float* AB, const float* convw, const float* a_log, const float* dt_bias,
                                          bf16* CHKA, bf16* CHKB, float* U, float* GL) {
    LAS unsigned char* L = F.lds;
    LAS float* tab = (LAS float*)(L + CK_TAB);
    const int w = F.wave;
    for (int item = F.vcu; item < NBATCH * 4 * 32; item += F.G) {
        int lane = F.lane; asm volatile("" : "+v"(lane));
        int li = lane & 15, lg = lane >> 4;
        const int n = item & 31, bh = item >> 5, h = bh & 3, b = bh >> 2;
        const size_t row0 = (size_t)b * SEQ + (size_t)n * 64;
        bf16* CH = ((item < 512) ? CHKA : CHKB) + (size_t)(item & 511) * (56 * 512);
        unsigned short xq[11][2], xk[11][2], xv[11][2];
#pragma unroll
        for (int k = 0; k < 11; ++k) {
            const int trel = 8 * w - 3 + k; const bool ok = (n * 64 + trel) >= 0;
            const bf16* rp = P + (row0 + trel) * PW + h * 128 + lane;
#pragma unroll
            for (int e = 0; e < 2; ++e) { xq[k][e] = ok ? rp[64 * e] : (unsigned short)0; xk[k][e] = ok ? rp[512 + 64 * e] : (unsigned short)0; xv[k][e] = ok ? rp[1024 + 64 * e] : (unsigned short)0; }
        }
        if (w == 0) {
            const float a = AB[(row0 + lane) * 8 + h], bb = AB[(row0 + lane) * 8 + 4 + h];
            const float xx = a + dt_bias[h];
            const float ey = __expf(xx);
            const float sp = (xx > 20.f) ? xx : ((ey < 0.01f) ? ey * (1.f - ey * (0.5f - ey * 0.33333333f)) : __logf(1.f + ey));
            const float gt = -__expf(a_log[h]) * sp;
            float gc = gt;
#pragma unroll
            for (int o = 1; o < 64; o <<= 1) { const float tv = __shfl_up(gc, o); if (lane >= o) gc += tv; }
            const float gl = __shfl(gc, 63);
            tab[lane] = gc; tab[64 + lane] = 1.f / (1.f + __expf(-bb)); tab[128 + lane] = __expf(gc); tab[192 + lane] = __expf(gl - gc);
            if (lane == 63) GL[item] = __expf(gc);
        }
        LDSO_BAR();
        {
            float cq[4][2], ck[4][2], cv[4][2];
#pragma unroll
            for (int j = 0; j < 4; ++j)
#pragma unroll
                for (int e = 0; e < 2; ++e) { const int c = h * 128 + lane + 64 * e; cq[j][e] = convw[j * 1536 + c]; ck[j][e] = convw[j * 1536 + 512 + c]; cv[j][e] = convw[j * 1536 + 1024 + c]; }
#pragma unroll
            for (int tt = 0; tt < 8; ++tt) {
                const int t = 8 * w + tt;
                float yq[2] = {0.f, 0.f}, yk[2] = {0.f, 0.f}, yv[2] = {0.f, 0.f};
#pragma unroll
                for (int j = 0; j < 4; ++j)
#pragma unroll
                    for (int e = 0; e < 2; ++e) { yq[e] += cq[j][e] * bf2f(xq[tt + j][e]); yk[e] += ck[j][e] * bf2f(xk[tt + j][e]); yv[e] += cv[j][e] * bf2f(xv[tt + j][e]); }
#pragma unroll
                for (int e = 0; e < 2; ++e) { yq[e] = silu_f(yq[e]); yk[e] = silu_f(yk[e]); yv[e] = silu_f(yv[e]); }
                const float rq = rsqrtf(wave_sum(yq[0] * yq[0] + yq[1] * yq[1]) + EPS) * 0.08838834764831845f;
                const float rk = rsqrtf(wave_sum(yk[0] * yk[0] + yk[1] * yk[1]) + EPS);
                const float bt = tab[64 + t], egt = tab[128 + t];
#pragma unroll
                for (int e = 0; e < 2; ++e) {
                    const int d = lane + 64 * e; const float qn = yq[e] * rq, kn = yk[e] * rk;
                    *(LAS unsigned short*)(L + CK_QB + t * 272 + 2 * d) = (unsigned short)f2bf(qn);
                    *(LAS unsigned short*)(L + CK_KB + t * 272 + 2 * d) = (unsigned short)f2bf(kn);
                    *(LAS unsigned short*)(L + CK_KT + d * 144 + 2 * t) = (unsigned short)f2bf(kn);
                    *(LAS unsigned short*)(L + CK_VBT + d * 144 + 2 * t) = (unsigned short)f2bf(yv[e] * bt);
                    *(LAS unsigned short*)(L + CK_KBET + d * 144 + 2 * t) = (unsigned short)f2bf(kn * bt * egt);
                }
            }
        }
        LDSO_BAR();
        asm volatile("" : "+v"(lane)); li = lane & 15; lg = lane >> 4;
        if (w < 6) {
            const int mblk = (w < 3) ? w : (w < 5 ? 2 + ((w - 3) >> 1) * 0 : 3);
            const int mb2 = (w == 3) ? 2 : (w >= 4 ? 3 : w);
            const int s = (w == 3 || w == 5) ? 1 : 0;
            (void)mblk;
            f32x4 kk[2], qk[2];
#pragma unroll
            for (int hf = 0; hf < 2; ++hf) { kk[hf] = (f32x4){0.f, 0.f, 0.f, 0.f}; qk[hf] = (f32x4){0.f, 0.f, 0.f, 0.f}; }
#pragma unroll
            for (int hf = 0; hf < 2; ++hf) {
                const int cb = 2 * s + hf;
                if (cb <= mb2) {
#pragma unroll
                    for (int ks = 0; ks < 4; ++ks) {
                        const s16x8 a = *(const LAS s16x8*)(L + CK_KB + (16 * cb + li) * 272 + 64 * ks + 16 * lg);
                        const s16x8 bk = *(const LAS s16x8*)(L + CK_KB + (16 * mb2 + li) * 272 + 64 * ks + 16 * lg);
                        const s16x8 bq = *(const LAS s16x8*)(L + CK_QB + (16 * mb2 + li) * 272 + 64 * ks + 16 * lg);
                        kk[hf] = mma16(a, bk, kk[hf]); qk[hf] = mma16(a, bq, qk[hf]);
                    }
                }
            }
            const int i = 16 * mb2 + li; const float gci = tab[i], bi = tab[64 + i];
            f32x4 qv[2];
#pragma unroll
            for (int hf = 0; hf < 2; ++hf) {
                const int cb = 2 * s + hf;
#pragma unroll
                for (int r = 0; r < 4; ++r) {
                    const int j = 16 * cb + 4 * lg + r;
                    const float dec = __expf(fminf(gci - tab[j], 0.f));
                    qv[hf][r] = (i >= j) ? qk[hf][r] * dec : 0.f;
                    kk[hf][r] = (i > j) ? bi * kk[hf][r] * dec : 0.f;
                    if (cb <= mb2) *(LAS float*)(L + CK_AT + j * 272 + 4 * i) = kk[hf][r];
                }
                if (mb2 >= 2 && s == 0) { u32x2v o; o.x = pk2(kk[hf][0], kk[hf][1]); o.y = pk2(kk[hf][2], kk[hf][3]); *(LAS u32x2v*)(L + CK_LR + (i - 32) * 80 + (16 * cb + 4 * lg) * 2) = o; }
            }
            *(GAS v4u*)(CH + (48 + mb2 * 2 + s) * 512 + lane * 8) = __builtin_bit_cast(v4u, pack8f(qv[0], qv[1]));
        } else {
            *(GAS v4u*)(CH + (48 + (w == 6 ? 1 : 3)) * 512 + lane * 8) = (v4u){0u, 0u, 0u, 0u};
        }
        LDSO_BAR();
        asm volatile("" : "+v"(lane)); li = lane & 15; lg = lane >> 4;
        if (w == 0) {
            const int half = lane >> 5, rl = lane & 31, base = 32 * half;
            float T[32];
#pragma unroll
            for (int j = 0; j < 32; ++j) T[j] = (j == rl) ? 1.f : 0.f;
#pragma unroll
            for (int c = 30; c >= 0; --c) {
                float a0 = 0.f, a1 = 0.f, a2 = 0.f, a3 = 0.f;
                unsigned aoff = (unsigned)(CK_AT + (base + c) * 272 + base * 4);
                if (c + 3 <= 31) asm volatile("" : "+v"(aoff) : "v"(T[c + 3]));
                const LAS float* ar = (const LAS float*)(L + aoff);
#pragma unroll
                for (int j4 = ((c + 1) >> 2); j4 < 8; ++j4) {
                    const f32x4 av = *(const LAS f32x4*)(ar + 4 * j4);
                    if (4 * j4 + 0 > c) a0 = fmaf(T[4 * j4 + 0], av[0], a0);
                    if (4 * j4 + 1 > c) a1 = fmaf(T[4 * j4 + 1], av[1], a1);
                    if (4 * j4 + 2 > c) a2 = fmaf(T[4 * j4 + 2], av[2], a2);
                    if (4 * j4 + 3 > c) a3 = fmaf(T[4 * j4 + 3], av[3], a3);
                }
                T[c] = (rl == c) ? 1.f : -((a0 + a1) + (a2 + a3));
            }
#pragma unroll
            for (int k8 = 0; k8 < 4; ++k8) {
                v4u o; o.x = pk2(T[8 * k8], T[8 * k8 + 1]); o.y = pk2(T[8 * k8 + 2], T[8 * k8 + 3]); o.z = pk2(T[8 * k8 + 4], T[8 * k8 + 5]); o.w = pk2(T[8 * k8 + 6], T[8 * k8 + 7]);
                *(LAS v4u*)(L + CK_TB + lane * 144 + 2 * base + 16 * k8) = o;
            }
            if (half == 0) {
#pragma unroll
                for (int k8 = 0; k8 < 4; ++k8) *(LAS v4u*)(L + CK_TB + lane * 144 + 64 + 16 * k8) = (v4u){0u, 0u, 0u, 0u};
#pragma unroll
                for (int c = 0; c < 32; ++c) *(LAS unsigned short*)(L + CK_T0T + c * 80 + 2 * rl) = (unsigned short)f2bf(T[c]);
            }
            asm volatile("s_waitcnt lgkmcnt(0)" ::: "memory");
            s16x8 lr[2], t0[2];
#pragma unroll
            for (int q = 0; q < 2; ++q) { lr[q] = *(const LAS s16x8*)(L + CK_LR + (16 * q + li) * 80 + 16 * lg); t0[q] = *(const LAS s16x8*)(L + CK_T0T + (16 * q + li) * 80 + 16 * lg); }
            s16x8 xb[2];
#pragma unroll
            for (int jb = 0; jb < 2; ++jb) { const f32x4 z4 = (f32x4){0.f, 0.f, 0.f, 0.f}; const f32x4 x0 = mma16(lr[0], t0[jb], z4), x1 = mma16(lr[1], t0[jb], z4); xb[jb] = pack8f(x0, x1); }
#pragma unroll
            for (int ib = 0; ib < 2; ++ib) {
                const u32x2v lo = *(const LAS u32x2v*)(L + CK_TB + (32 + 16 * ib + li) * 144 + (32 + 4 * lg) * 2), hi = *(const LAS u32x2v*)(L + CK_TB + (32 + 16 * ib + li) * 144 + (48 + 4 * lg) * 2);
                const s16x8 a = __builtin_bit_cast(s16x8, (v4u){lo.x, lo.y, hi.x, hi.y});
#pragma unroll
                for (int jb = 0; jb < 2; ++jb) { const f32x4 d = mma16(a, xb[jb], (f32x4){0.f, 0.f, 0.f, 0.f});
#pragma unroll
                    for (int r = 0; r < 4; ++r) *(LAS unsigned short*)(L + CK_TB + (32 + 16 * ib + 4 * lg + r) * 144 + 2 * (16 * jb + li)) = (unsigned short)f2bf(-d[r]); }
            }
        } else {
            for (int f = w - 1; f < 32; f += 7) {
                if (f < 16) {
                    const int mblk = f >> 2, s = f & 3, i = 16 * mblk + li; const float e = tab[128 + i];
                    const u32x2v lo = *(const LAS u32x2v*)(L + CK_QB + i * 272 + (32 * s + 4 * lg) * 2), hi = *(const LAS u32x2v*)(L + CK_QB + i * 272 + (32 * s + 16 + 4 * lg) * 2);
                    v4u o; o.x = pk2(bflo(lo.x) * e, bfhi(lo.x) * e); o.y = pk2(bflo(lo.y) * e, bfhi(lo.y) * e); o.z = pk2(bflo(hi.x) * e, bfhi(hi.x) * e); o.w = pk2(bflo(hi.y) * e, bfhi(hi.y) * e);
                    *(GAS v4u*)(CH + (16 + f) * 512 + lane * 8) = o;
                } else {
                    const int f2 = f - 16, dblk = f2 >> 1, s = f2 & 1, d = 16 * dblk + li, c0 = 32 * s + 4 * lg, c1 = c0 + 16;
                    const u32x2v lo = *(const LAS u32x2v*)(L + CK_KT + d * 144 + c0 * 2), hi = *(const LAS u32x2v*)(L + CK_KT + d * 144 + c1 * 2);
                    const f32x4 e0 = *(const LAS f32x4*)(tab + 192 + c0), e1 = *(const LAS f32x4*)(tab + 192 + c1);
                    v4u o; o.x = pk2(bflo(lo.x) * e0[0], bfhi(lo.x) * e0[1]); o.y = pk2(bflo(lo.y) * e0[2], bfhi(lo.y) * e0[3]); o.z = pk2(bflo(hi.x) * e1[0], bfhi(hi.x) * e1[1]); o.w = pk2(bflo(hi.y) * e1[2], bfhi(hi.y) * e1[3]);
                    *(GAS v4u*)(CH + (32 + f2) * 512 + lane * 8) = o;
                }
            }
        }
        LDSO_BAR();
        asm volatile("" : "+v"(lane)); li = lane & 15; lg = lane >> 4;
        {
            s16x8 tb[4][2];
#pragma unroll
            for (int mb = 0; mb < 4; ++mb)
#pragma unroll
                for (int s = 0; s < 2; ++s) tb[mb][s] = *(const LAS s16x8*)(L + CK_TB + (16 * mb + li) * 144 + 64 * s + 16 * lg);
            s16x8 vb[2], kb[2];
#pragma unroll
            for (int s = 0; s < 2; ++s) { vb[s] = *(const LAS s16x8*)(L + CK_VBT + (16 * w + li) * 144 + 64 * s + 16 * lg); kb[s] = *(const LAS s16x8*)(L + CK_KBET + (16 * w + li) * 144 + 64 * s + 16 * lg); }
#pragma unroll
            for (int mb = 0; mb < 4; ++mb) {
                f32x4 u = (f32x4){0.f, 0.f, 0.f, 0.f}, wv = (f32x4){0.f, 0.f, 0.f, 0.f};
#pragma unroll
                for (int s = 0; s < 2; ++s) { u = mma16(tb[mb][s], vb[s], u); wv = mma16(kb[s], tb[mb][s], wv); }
                *(GAS f32x4*)(U + (((size_t)item * 8 + w) * 4 + mb) * 256 + lane * 4) = u;
                u32x2v o; o.x = pk2(-wv[0], -wv[1]); o.y = pk2(-wv[2], -wv[3]);
                *(GAS u32x2v*)(CH + (mb * 4 + (w >> 1)) * 512 + lane * 8 + 4 * (w & 1)) = o;
            }
        }
        LDSO_BAR();
    }
}
constexpr int SC_BUFB = 57344, SC_PART = 2 * SC_BUFB;
__device__ __forceinline__ void gdn_scan(Frame& F, int bh, const bf16* CHKA, const bf16* CHKB, const float* U, const float* GL, const float* ng, bf16* P) {
    LAS unsigned char* L = F.lds;
    LAS float* part = (LAS float*)(L + SC_PART);
    const int w = F.wave, lane = F.lane, li = lane & 15, lg = lane >> 4;
    const int b = bh >> 2, h = bh & 3;
    f32x4 S[8];
#pragma unroll
    for (int k = 0; k < 8; ++k) S[k] = (f32x4){0.f, 0.f, 0.f, 0.f};
    f32x4 ucur[4], unext[4], oprev[4];
    unsigned short znext[4][4], zcur[4][4], zfin[4][4];
    const bf16* pz = P + (size_t)b * SEQ * PW + 1536 + h * 128 + 16 * w + li;
    const bf16* chbase = ((bh < 16) ? CHKA : CHKB) + (size_t)((bh & 15) * 32) * (56 * 512);
    const float gcol = ng[16 * w + li];
    const float glv = GL[bh * 32 + (lane & 31)];
#pragma unroll
    for (int k = 0; k < 4; ++k) { unext[k] = (f32x4){0.f, 0.f, 0.f, 0.f}; oprev[k] = (f32x4){0.f, 0.f, 0.f, 0.f};
#pragma unroll
        for (int r2 = 0; r2 < 4; ++r2) { znext[k][r2] = 0; zcur[k][r2] = 0; zfin[k][r2] = 0; } }
#define SC_ISSUE(nn) do { const size_t ch_ = (size_t)bh * 32 + (nn); const int bo_ = ((nn) & 1) * SC_BUFB; \
        const bf16* src_ = chbase + (size_t)(nn) * (56 * 512) + (size_t)(w * 7) * 512 + lane * 8; \
        _Pragma("unroll") for (int k_ = 0; k_ < 7; ++k_) \
            __builtin_amdgcn_global_load_lds((const unsigned*)(src_ + k_ * 512), (LAS unsigned*)(L + bo_ + (w * 7 + k_) * 1024), 16, 0, 0); \
        _Pragma("unroll") for (int mb_ = 0; mb_ < 4; ++mb_) unext[mb_] = *(const GAS f32x4*)(U + ((ch_ * 8 + w) * 4 + mb_) * 256 + lane * 4); \
        _Pragma("unroll") for (int mb_ = 0; mb_ < 4; ++mb_) _Pragma("unroll") for (int r_ = 0; r_ < 4; ++r_) znext[mb_][r_] = pz[(size_t)((nn) * 64 + 16 * mb_ + 4 * lg + r_) * PW]; } while (0)
#define SC_FINISH(nn) do { const LAS float* pp_ = part + ((nn) & 1) * 512; const float gcol_ = gcol; const int col_ = h * 128 + 16 * w + li; \
        _Pragma("unroll") for (int mb_ = 0; mb_ < 4; ++mb_) _Pragma("unroll") for (int r_ = 0; r_ < 4; ++r_) { const int row_ = 16 * mb_ + 4 * lg + r_; \
            const f32x4 p0_ = *(const LAS f32x4*)(pp_ + row_ * 8), p1_ = *(const LAS f32x4*)(pp_ + row_ * 8 + 4); \
            const float tot_ = ((p0_[0] + p0_[1]) + (p0_[2] + p0_[3])) + ((p1_[0] + p1_[1]) + (p1_[2] + p1_[3])); \
            const float rs_ = rsqrtf(tot_ * (1.f / 128.f) + EPS); \
            bf16* pr_ = P + ((size_t)b * SEQ + (size_t)(nn) * 64 + row_) * PW; \
            const float z_ = bf2f(zfin[mb_][r_]); \
            pr_[col_] = (bf16)f2bf(oprev[mb_][r_] * rs_ * gcol_ * silu_f(z_)); } } while (0)
    SC_ISSUE(0);
    for (int n = 0; n < 32; ++n) {
        LDS_BAR();
#pragma unroll
        for (int k = 0; k < 4; ++k) { ucur[k] = unext[k];
#pragma unroll
            for (int r2 = 0; r2 < 4; ++r2) zcur[k][r2] = znext[k][r2]; }
        if (n > 0) SC_FINISH(n - 1);
        if (n + 1 < 32) SC_ISSUE(n + 1);
        const LAS unsigned char* B = L + (n & 1) * SC_BUFB;
        s16x8 sb[4];
#pragma unroll
        for (int s = 0; s < 4; ++s) sb[s] = pack8f(S[2 * s], S[2 * s + 1]);
        f32x4 vn[4], o[4];
#pragma unroll
        for (int mb = 0; mb < 4; ++mb) { vn[mb] = ucur[mb]; o[mb] = (f32x4){0.f, 0.f, 0.f, 0.f}; }
#pragma unroll
        for (int hb = 0; hb < 2; ++hb) {
            s16x8 aw[2][4], aq[2][4];
#pragma unroll
            for (int m2 = 0; m2 < 2; ++m2)
#pragma unroll
                for (int s = 0; s < 4; ++s) { aw[m2][s] = *(const LAS s16x8*)(B + ((2 * hb + m2) * 4 + s) * 1024 + lane * 16); aq[m2][s] = *(const LAS s16x8*)(B + 16384 + ((2 * hb + m2) * 4 + s) * 1024 + lane * 16); }
            __builtin_amdgcn_sched_barrier(0);
#pragma unroll
            for (int s = 0; s < 4; ++s)
#pragma unroll
                for (int m2 = 0; m2 < 2; ++m2) { vn[2 * hb + m2] = mma16(aw[m2][s], sb[s], vn[2 * hb + m2]); o[2 * hb + m2] = mma16(aq[m2][s], sb[s], o[2 * hb + m2]); }
            __builtin_amdgcn_sched_barrier(0);
        }
        s16x8 vb[2];
#pragma unroll
        for (int s = 0; s < 2; ++s) vb[s] = pack8f(vn[2 * s], vn[2 * s + 1]);
        {
            s16x8 aqk[4][2], akd[4][2];
#pragma unroll
            for (int mb = 0; mb < 4; ++mb)
#pragma unroll
                for (int s = 0; s < 2; ++s) { aqk[mb][s] = *(const LAS s16x8*)(B + 49152 + (mb * 2 + s) * 1024 + lane * 16); akd[mb][s] = *(const LAS s16x8*)(B + 32768 + (mb * 2 + s) * 1024 + lane * 16); }
            const float gl = rdlane(glv, n);
#pragma unroll
            for (int db = 0; db < 8; ++db) S[db] = S[db] * gl;
            __builtin_amdgcn_sched_barrier(0);
#pragma unroll
            for (int s = 0; s < 2; ++s)
#pragma unroll
                for (int mb = 0; mb < 4; ++mb) { o[mb] = mma16(aqk[mb][s], vb[s], o[mb]); S[mb] = mma16(akd[mb][s], vb[s], S[mb]); }
            __builtin_amdgcn_sched_barrier(0);
            s16x8 akd2[4][2];
#pragma unroll
            for (int mb = 0; mb < 4; ++mb)
#pragma unroll
                for (int s = 0; s < 2; ++s) akd2[mb][s] = *(const LAS s16x8*)(B + 32768 + ((4 + mb) * 2 + s) * 1024 + lane * 16);
            __builtin_amdgcn_sched_barrier(0);
#pragma unroll
            for (int s = 0; s < 2; ++s)
#pragma unroll
                for (int mb = 0; mb < 4; ++mb) S[4 + mb] = mma16(akd2[mb][s], vb[s], S[4 + mb]);
            __builtin_amdgcn_sched_barrier(0);
        }
        LAS float* pw = part + (n & 1) * 512;
#pragma unroll
        for (int mb = 0; mb < 4; ++mb)
#pragma unroll
            for (int r = 0; r < 4; ++r) { const float p = row16_sum(o[mb][r] * o[mb][r]);
                if (li == 0) pw[(16 * mb + 4 * lg + r) * 8 + w] = p; }
#pragma unroll
        for (int k = 0; k < 4; ++k) { oprev[k] = o[k];
#pragma unroll
            for (int r2 = 0; r2 < 4; ++r2) zfin[k][r2] = zcur[k][r2]; }
    }
    LDS_BAR();
    SC_FINISH(31);
    LDS_BAR();
#undef SC_ISSUE
#undef SC_FINISH
}

typedef float f32x16 __attribute__((ext_vector_type(16)));
typedef short v4i16_t __attribute__((ext_vector_type(4)));
__device__ __forceinline__ f32x16 mma32(s16x8 a, s16x8 b, f32x16 c) { return __builtin_amdgcn_mfma_f32_32x32x16_bf16(a, b, c, 0, 0, 0); }
constexpr int SW_OACC = 0, SW_MACC = 65536, SW_LACC = 66560, SW_WSCR = 67584, SW_WSZ = 5120;
__device__ __forceinline__ void swa_unit(Frame& F, bf16* P, int unit) {
    LAS unsigned char* L = F.lds;
    LAS float* Oacc = (LAS float*)(L + SW_OACC); LAS float* Macc = (LAS float*)(L + SW_MACC); LAS float* Lacc = (LAS float*)(L + SW_LACC);
    const int w = F.wave;
    int lane = F.lane; asm volatile("" : "+v"(lane));
    const int r = lane & 31, hh = lane >> 5;
    LAS unsigned char* vt = L + SW_WSCR + w * SW_WSZ; LAS float* sc = (LAS float*)(vt + 4608);
    const int tb = unit & 7, h = (unit >> 3) & 7, b = unit >> 6, t0 = tb * 256;
    const float slope2 = exp2f(-(float)(h + 1)) * 1.4426950408889634f;
    const bf16* base = P + (size_t)b * SEQ * PW + 2048 + h * 64;
    for (int pass = 0; pass < 3; ++pass) {
        const int d = (pass == 0) ? 1 : (pass == 1 ? 4 : 16), dsh = 2 * pass;
        const int nrb = (pass == 2) ? 2 : 1;
        for (int ri = 0; ri < nrb; ++ri) {
            int c, qs0;
            if (pass == 0) { c = 0; qs0 = t0 + 32 * w; } else if (pass == 1) { c = w >> 1; qs0 = (t0 >> 2) + 32 * (w & 1); } else { c = 2 * w + ri; qs0 = (t0 >> 4) & ~31; }
            const int tq = ((qs0 + r) << dsh) + c;
            s16x8 qf[4];
            { const bf16* qp = base + (size_t)tq * PW + 8 * hh;
#pragma unroll
              for (int s = 0; s < 4; ++s) qf[s] = *(const GAS s16x8*)(qp + 16 * s); }
            f32x16 o0, o1;
#pragma unroll
            for (int v = 0; v < 16; ++v) { o0[v] = 0.f; o1[v] = 0.f; }
            float mrun = -INFINITY, lrun = 0.f;
            const int kb0 = qs0 >> 5;
            for (int kb = kb0; kb >= 0 && kb >= kb0 - 4; --kb) {
                const int ks0 = kb * 32;
                const int tk = ((ks0 + r) << dsh) + c;
                s16x8 kf[4];
                { const bf16* kp = base + (size_t)tk * PW + 512 + 8 * hh;
#pragma unroll
                  for (int s = 0; s < 4; ++s) kf[s] = *(const GAS s16x8*)(kp + 16 * s); }
                { const int vk = lane >> 1, vh = lane & 1; const bf16* vp = base + (size_t)((((ks0 + vk) << dsh) + c)) * PW + 1024 + 32 * vh;
#pragma unroll
                  for (int i = 0; i < 4; ++i) { const v4u x = *(const GAS v4u*)(vp + 8 * i); *(LAS v4u*)(vt + vk * 144 + vh * 64 + 16 * i) = x; } }
                f32x16 st;
#pragma unroll
                for (int v = 0; v < 16; ++v) st[v] = 0.f;
#pragma unroll
                for (int s = 0; s < 4; ++s) st = mma32(kf[s], qf[s], st);
                const int qsub = qs0 + r;
                float bm = -INFINITY;
#pragma unroll
                for (int v = 0; v < 16; ++v) {
                    const int ksub = ks0 + (v & 3) + 8 * (v >> 2) + 4 * hh, dl = qsub - ksub;
                    const float x = st[v] * 0.18033688011112042f - slope2 * (float)(dl << dsh);
                    st[v] = (dl >= 0 && dl <= 128) ? x : -INFINITY;
                    bm = fmaxf(bm, st[v]);
                }
                bm = fmaxf(bm, __shfl_xor(bm, 32));
                const float mn = fmaxf(mrun, bm);
                const float alpha = exp2f(mrun - mn);
                float rs = 0.f;
#pragma unroll
                for (int v = 0; v < 16; ++v) { st[v] = exp2f(st[v] - mn); rs += st[v]; }
                rs += __shfl_xor(rs, 32);
                lrun = lrun * alpha + rs; mrun = mn;
                if (hh == 0) sc[r] = alpha;
                asm volatile("s_waitcnt lgkmcnt(0)" ::: "memory");
                s16x8 pf[2];
#pragma unroll
                for (int s = 0; s < 2; ++s) { v4u x; x.x = pk2(st[8 * s], st[8 * s + 1]); x.y = pk2(st[8 * s + 2], st[8 * s + 3]); x.z = pk2(st[8 * s + 4], st[8 * s + 5]); x.w = pk2(st[8 * s + 6], st[8 * s + 7]); pf[s] = __builtin_bit_cast(s16x8, x); }
#pragma unroll
                for (int g4 = 0; g4 < 4; ++g4) { const f32x4 a4 = *(const LAS f32x4*)(sc + 8 * g4 + 4 * hh);
#pragma unroll
                    for (int e = 0; e < 4; ++e) { o0[4 * g4 + e] *= a4[e]; o1[4 * g4 + e] *= a4[e]; } }
                { const int gi = lane & 15, q = gi >> 2, p4 = gi & 3, G = lane >> 4; const int dimb = 16 * (G & 1) + 4 * p4;
#pragma unroll
                  for (int s = 0; s < 2; ++s)
#pragma unroll
                      for (int nb = 0; nb < 2; ++nb) {
                          const LAS unsigned char* a0 = vt + (16 * s + 4 * hh + q) * 144 + (dimb + 32 * nb) * 2;
                          const v4i16_t lo = __builtin_amdgcn_ds_read_tr16_b64_v4i16((LAS v4i16_t*)a0), hi = __builtin_amdgcn_ds_read_tr16_b64_v4i16((LAS v4i16_t*)(a0 + 8 * 144));
                          const s16x8 vf = (s16x8){lo[0], lo[1], lo[2], lo[3], hi[0], hi[1], hi[2], hi[3]};
                          if (nb == 0) o0 = mma32(pf[s], vf, o0); else o1 = mma32(pf[s], vf, o1);
                      } }
                asm volatile("s_waitcnt lgkmcnt(0)" ::: "memory");
            }
            if (hh == 0) { sc[32 + r] = mrun; sc[64 + r] = lrun; }
            asm volatile("s_waitcnt lgkmcnt(0)" ::: "memory");
#pragma unroll
            for (int v = 0; v < 16; ++v) {
                const int qr = (v & 3) + 8 * (v >> 2) + 4 * hh;
                const int tl = ((qs0 + qr) << dsh) + c - t0;
                if (tl >= 0 && tl < 256) {
                    const float mb = sc[32 + qr];
                    if (pass == 0) { Oacc[tl * 64 + r] = o0[v]; Oacc[tl * 64 + 32 + r] = o1[v]; if (r == 0) { Macc[tl] = mb; Lacc[tl] = sc[64 + qr]; } }
                    else { const float mo = Macc[tl], mn = fmaxf(mo, mb), fo = exp2f(mo - mn), fb = exp2f(mb - mn);
                        Oacc[tl * 64 + r] = Oacc[tl * 64 + r] * fo + o0[v] * fb; Oacc[tl * 64 + 32 + r] = Oacc[tl * 64 + 32 + r] * fo + o1[v] * fb;
                        asm volatile("s_waitcnt lgkmcnt(0)" ::: "memory");
                        if (r == 0) { Lacc[tl] = Lacc[tl] * fo + sc[64 + qr] * fb; Macc[tl] = mn; } }
                }
            }
            asm volatile("s_waitcnt lgkmcnt(0)" ::: "memory");
        }
        LDS_BAR();
    }
    { const int tl = F.tid >> 1, hf = F.tid & 1; const float il = 1.f / Lacc[tl];
      bf16* op = P + ((size_t)b * SEQ + t0 + tl) * PW + 512 + h * 64 + 32 * hf;
#pragma unroll
      for (int i = 0; i < 4; ++i) { const f32x4 x0 = *(const LAS f32x4*)(Oacc + tl * 64 + 32 * hf + 8 * i), x1 = *(const LAS f32x4*)(Oacc + tl * 64 + 32 * hf + 8 * i + 4);
          v4u o; o.x = pk2(x0[0] * il, x0[1] * il); o.y = pk2(x0[2] * il, x0[3] * il); o.z = pk2(x1[0] * il, x1[1] * il); o.w = pk2(x1[2] * il, x1[3] * il);
          *(GAS v4u*)(op + 8 * i) = o; } }
    LDS_BAR();
}

constexpr int XA_K = 0, XA_V = 16896, XA_SC = 33792;
__device__ __forceinline__ void xattn_unit(Frame& F, const bf16* Q, const bf16* KM, const bf16* VM, bf16* O, int unit) {
    LAS unsigned char* L = F.lds;
    const int w = F.wave;
    int lane = F.lane; asm volatile("" : "+v"(lane));
    int tid = F.tid; asm volatile("" : "+v"(tid));
    const int r = lane & 31, hh = lane >> 5;
    LAS float* sc = (LAS float*)(L + XA_SC + w * 128);
    const int qb = unit & 7, hd = (unit >> 3) & 3, b = unit >> 5;
    const size_t qrow = (size_t)b * SEQ + qb * 256 + w * 32 + r;
    const bf16* qp = Q + qrow * DM + hd * 256 + 8 * hh;
    f32x16 o[8];
#pragma unroll
    for (int nb = 0; nb < 8; ++nb)
#pragma unroll
        for (int v = 0; v < 16; ++v) o[nb][v] = 0.f;
    float mrun = -INFINITY, lrun = 0.f;
    for (int kb = 0; kb < 8; ++kb) {
        LDS_BAR();
#pragma unroll
        for (int i = 0; i < 2; ++i) { const int pc = tid + 512 * i, key = pc >> 5, ch = pc & 31;
            const size_t src = ((size_t)b * NMEM + kb * 32 + key) * DM + hd * 256 + ch * 8;
            const v4u kx = *(const GAS v4u*)(KM + src), vx = *(const GAS v4u*)(VM + src);
            *(LAS v4u*)(L + XA_K + key * 528 + ch * 16) = kx; *(LAS v4u*)(L + XA_V + key * 528 + ch * 16) = vx; }
        LDS_BAR();
        f32x16 st;
#pragma unroll
        for (int v = 0; v < 16; ++v) st[v] = 0.f;
#pragma unroll
        for (int s = 0; s < 16; ++s) { const s16x8 a = *(const LAS s16x8*)(L + XA_K + r * 528 + 32 * s + 16 * hh); const s16x8 bq = *(const GAS s16x8*)(qp + 16 * s); st = mma32(a, bq, st); }
        float bm = -INFINITY;
#pragma unroll
        for (int v = 0; v < 16; ++v) { st[v] *= 0.09016844005556021f; bm = fmaxf(bm, st[v]); }
        bm = fmaxf(bm, __shfl_xor(bm, 32));
        const float mn = fmaxf(mrun, bm), alpha = exp2f(mrun - mn);
        float rs = 0.f;
#pragma unroll
        for (int v = 0; v < 16; ++v) { st[v] = exp2f(st[v] - mn); rs += st[v]; }
        rs += __shfl_xor(rs, 32);
        lrun = lrun * alpha + rs; mrun = mn;
        if (hh == 0) sc[r] = alpha;
        asm volatile("s_waitcnt lgkmcnt(0)" ::: "memory");
        s16x8 pf[2];
#pragma unroll
        for (int s = 0; s < 2; ++s) { v4u x; x.x = pk2(st[8 * s], st[8 * s + 1]); x.y = pk2(st[8 * s + 2], st[8 * s + 3]); x.z = pk2(st[8 * s + 4], st[8 * s + 5]); x.w = pk2(st[8 * s + 6], st[8 * s + 7]); pf[s] = __builtin_bit_cast(s16x8, x); }
        f32x4 a4[4];
#pragma unroll
        for (int g4 = 0; g4 < 4; ++g4) a4[g4] = *(const LAS f32x4*)(sc + 8 * g4 + 4 * hh);
        const int gi = lane & 15, q = gi >> 2, p4 = gi & 3, G = lane >> 4; const int dimb = 16 * (G & 1) + 4 * p4;
#pragma unroll
        for (int nb = 0; nb < 8; ++nb) {
#pragma unroll
            for (int g4 = 0; g4 < 4; ++g4)
#pragma unroll
                for (int e = 0; e < 4; ++e) o[nb][4 * g4 + e] *= a4[g4][e];
#pragma unroll
            for (int s = 0; s < 2; ++s) {
                const LAS unsigned char* a0 = L + XA_V + (16 * s + 4 * hh + q) * 528 + (dimb + 32 * nb) * 2;
                const v4i16_t lo = __builtin_amdgcn_ds_read_tr16_b64_v4i16((LAS v4i16_t*)a0), hi = __builtin_amdgcn_ds_read_tr16_b64_v4i16((LAS v4i16_t*)(a0 + 8 * 528));
                const s16x8 vf = (s16x8){lo[0], lo[1], lo[2], lo[3], hi[0], hi[1], hi[2], hi[3]};
                o[nb] = mma32(pf[s], vf, o[nb]);
            }
        }
    }
    if (hh == 0) sc[r] = 1.f / lrun;
    asm volatile("s_waitcnt lgkmcnt(0)" ::: "memory");
    f32x4 il[4];
#pragma unroll
    for (int g4 = 0; g4 < 4; ++g4) il[g4] = *(const LAS f32x4*)(sc + 8 * g4 + 4 * hh);
    bf16* ob = O + ((size_t)b * SEQ + qb * 256 + w * 32) * DM + hd * 256 + r;
#pragma unroll
    for (int nb = 0; nb < 8; ++nb)
#pragma unroll
        for (int v = 0; v < 16; ++v) { const int qr = (v & 3) + 8 * (v >> 2) + 4 * hh; ob[(size_t)qr * DM + 32 * nb] = (bf16)f2bf(o[nb][v] * il[v >> 2][v & 3]); }
    LDS_BAR();
}

struct Args { const float* in[27]; float* out; unsigned char* ws; };
__global__ void __launch_bounds__(NTHREADS, 2) mk_fwd(Args args) {
    extern __shared__ __attribute__((aligned(16))) unsigned char lds[];
    Frame F;
    F.lds = (LAS unsigned char*)lds;
    F.MISC = (volatile LAS unsigned*)(F.lds + MISC_OFF);
    F.tid = threadIdx.x; F.lane = F.tid & 63; F.wave = __builtin_amdgcn_readfirstlane(F.tid >> 6);
    F.G = gridDim.x; { const int bx = blockIdx.x; F.vcu = (F.G % 8 == 0) ? (bx % 8) * (F.G / 8) + bx / 8 : bx; }
    unsigned char* ws = args.ws;
    F.ctl = (gu32*)(ws + WS_CTL);
    for (int u = F.tid; u < (LDS_BYTES - LDSCTL_OFF) / 4; u += NTHREADS) ((LAS unsigned*)(F.lds + LDSCTL_OFF))[u] = 0u;
    __syncthreads();
    XcdBarrier bar = xcd_barrier_post((unsigned*)(F.ctl + CW_BAR), F.MISC + 8);
#define GRID_BAR() do { xcd_barrier(bar); F.tid = threadIdx.x; asm volatile("" : "+v"(F.tid)); F.lane = F.tid & 63; } while (0)
    float* out = (float*)INP(27);
    bf16* XN = (bf16*)(ws + WS_XN); bf16* HB = (bf16*)(ws + WS_HB); bf16* PROJ = (bf16*)(ws + WS_PROJ); bf16* T1 = (bf16*)(ws + WS_T1); bf16* QB = (bf16*)(ws + WS_Q);
    bf16* KM = (bf16*)(ws + WS_KM); bf16* VM = (bf16*)(ws + WS_VM); float* AB = (float*)(ws + WS_AB);
    const int bid = (int)blockIdx.x;

    enum { K_PRO = 0, K_SWIGLU, K_GBF16, K_NORM, K_PROJ, K_CHUNK, K_SCAN, K_XATTN };
#pragma unroll 1
    for (int ph = 0; ph < 16; ++ph) {
        int kind = K_PRO; size_t wA = 0, wB = 0, wO = 0; int K = DM, lda = DM; int gx = 0, g1 = 0, g2 = -1; float sc = 1.f;
        switch (ph) {
            case 0:  kind = K_PRO; break;
            case 1:  kind = K_SWIGLU; wB = WS_W1GU; break;
            case 2:  kind = K_GBF16; wA = WS_HB; wB = WS_W1D; wO = WS_T1; K = DFF; lda = DFF; break;
            case 3:  kind = K_NORM; gx = 0; g1 = 6; g2 = 7; sc = 0.5f; break;
            case 4:  kind = K_PROJ; break;
            case 5:  kind = K_CHUNK; break;
            case 6:  kind = K_SCAN; break;
            case 7:  kind = K_GBF16; wA = WS_PROJ; wB = WS_WOUT; wO = WS_T1; K = DM; lda = PW; break;
            case 8:  kind = K_NORM; gx = 27; g1 = 14; g2 = 15; break;
            case 9:  kind = K_GBF16; wA = WS_XN; wB = WS_WQ; wO = WS_Q; break;
            case 10: kind = K_XATTN; break;
            case 11: kind = K_GBF16; wA = WS_XN; wB = WS_WO; wO = WS_T1; break;
            case 12: kind = K_NORM; gx = 27; g1 = 21; g2 = 22; break;
            case 13: kind = K_SWIGLU; wB = WS_W2GU; break;
            case 14: kind = K_GBF16; wA = WS_HB; wB = WS_W2D; wO = WS_T1; K = DFF; lda = DFF; break;
            default: kind = K_NORM; gx = 27; g1 = 26; g2 = -1; sc = 0.5f; break;
        }
        if (kind == K_PRO) p0_prologue(F, ws);
        else if (kind == K_SWIGLU) { pg8::Gemm g{XN, (const bf16*)(ws + wB), MTOK, 2 * DFF, DM, DM}; pg8::StaticOrder S; S.init(MTOK, 2 * DFF, F.G, bid); pg8::EpiSwiglu E{HB, DFF};
            pg8::gemm_phase<pg8::EpiSwiglu, pg8::StaticOrder, true, true>(F.lds + RING_OFF, g, S, E); }
        else if (kind == K_GBF16) { pg8::Gemm g{(const bf16*)(ws + wA), (const bf16*)(ws + wB), MTOK, DM, K, lda}; pg8::StaticOrder S; S.init(MTOK, DM, F.G, bid); pg8::EpiBf16 E{(bf16*)(ws + wO), DM};
            pg8::gemm_phase<pg8::EpiBf16, pg8::StaticOrder, true, true>(F.lds + RING_OFF, g, S, E); }
        else if (kind == K_NORM) norm_pass(F, INP(gx), T1, INP(g1), sc, out, g2 >= 0 ? INP(g2) : nullptr, XN);
        else if (kind == K_PROJ) { pg8::Gemm g{XN, (const bf16*)(ws + WS_WIN), MTOK + MMEM, 3840 + 2048, DM, DM}; pg8::ProjKvOrder S; S.init(F.G, bid); pg8::EpiProjKv E{PROJ, AB, KM, VM};
            pg8::gemm_phase<pg8::EpiProjKv, pg8::ProjKvOrder, true, true>(F.lds + RING_OFF, g, S, E); }
        else if (kind == K_CHUNK) gdn_chunk(F, PROJ, AB, INP(9), INP(10), INP(11), (bf16*)(ws + WS_CHKA), (bf16*)(ws + WS_CHKB), (float*)(ws + WS_CU), (float*)(ws + WS_GL));
        else if (kind == K_SCAN) { if (bid < 32) gdn_scan(F, bid, (const bf16*)(ws + WS_CHKA), (const bf16*)(ws + WS_CHKB), (const float*)(ws + WS_CU), (const float*)(ws + WS_GL), INP(12), PROJ);
                                   else { for (int u = bid - 32; u < NBATCH * 8 * 8; u += F.G - 32) swa_unit(F, PROJ, u); } }
        else { for (int u = F.vcu; u < NBATCH * 4 * 8; u += F.G) xattn_unit(F, QB, KM, VM, XN, u); }
        if (ph < 15) GRID_BAR();
    }
#undef GRID_BAR
}

extern "C" void kernel_launch(void* const* d_in, const int* in_sizes, int n_in, void* d_out, int out_size, void* d_ws, size_t ws_size, hipStream_t stream) {
    static int grid = 0;
    if (grid == 0) {
        if (n_in != 27 || out_size != MTOK * DM || ws_size < WS_END) { fprintf(stderr, "kernel_launch: unexpected shapes (n_in %d, out %d, ws %zu)\n", n_in, out_size, ws_size); grid = -1; return; }
        int dev = 0, cus = 0, per_cu = 0;
        if (hipGetDevice(&dev) != hipSuccess || hipDeviceGetAttribute(&cus, hipDeviceAttributeMultiprocessorCount, dev) != hipSuccess) { grid = -1; return; }
        if (hipFuncSetAttribute((const void*)mk_fwd, hipFuncAttributeMaxDynamicSharedMemorySize, LDS_BYTES) != hipSuccess) { fprintf(stderr, "kernel_launch: hipFuncSetAttribute failed\n"); grid = -1; return; }
        if (hipOccupancyMaxActiveBlocksPerMultiprocessor(&per_cu, (const void*)mk_fwd, NTHREADS, LDS_BYTES) != hipSuccess || per_cu < 1) fprintf(stderr, "kernel_launch: occupancy query reports %d\n", per_cu);
        (void)hipGetLastError();
        grid = cus;
    }
    if (grid < 0) return;
    if (hipMemsetAsync((char*)d_ws + WS_CTL, 0, CTL_ZERO_BYTES, stream) != hipSuccess) return;
    Args a{};
    for (int i = 0; i < 27; ++i) a.in[i] = (const float*)d_in[i];
    a.out = (float*)d_out; a.ws = (unsigned char*)d_ws;
    hipLaunchKernelGGL(mk_fwd, dim3(grid), dim3(NTHREADS), LDS_BYTES, stream, a);
}
```
